# Optimizing an MI355X kernel written in HIP

```python
import jax, jax.numpy as jnp
from jax import lax
import numpy as np

D_MODEL = 1024
BATCH = 4
SEQ = 4096
DEPTH = 2
DEC_BATCH = 8
DEC_SEQ = 4096
PAST_LEN = 128

HEAD_DIM = 64
N_Q_HEADS = 8
N_KV_HEADS = 2
Q_PER_KV = N_Q_HEADS // N_KV_HEADS
ATTN_WIDTH = N_Q_HEADS * HEAD_DIM
KV_WIDTH = N_KV_HEADS * HEAD_DIM
FOURIER_WIDTH = D_MODEL - ATTN_WIDTH
N_FOURIER_GROUPS = 4
FOURIER_GROUP_DIM = FOURIER_WIDTH // N_FOURIER_GROUPS
MIX_WIDTH = ATTN_WIDTH + FOURIER_WIDTH
IN_WIDTH = ATTN_WIDTH + 2 * KV_WIDTH + ATTN_WIDTH + FOURIER_WIDTH + FOURIER_WIDTH
IN_SPLITS = (ATTN_WIDTH,
             ATTN_WIDTH + KV_WIDTH,
             ATTN_WIDTH + 2 * KV_WIDTH,
             2 * ATTN_WIDTH + 2 * KV_WIDTH,
             2 * ATTN_WIDTH + 2 * KV_WIDTH + FOURIER_WIDTH)
WINDOW = 128
BLOCK = 128
ROPE_THETA = 10000.0
EPS = 1e-6
NEG = -1e30

kernel_name = 'hymba_window_sink_gqa_fnet_encoder'


def rms_norm(x, gain):
    xf = x.astype(jnp.float32)
    xf = xf * lax.rsqrt(jnp.mean(xf * xf, axis=-1, keepdims=True) + EPS)
    return (xf * gain.astype(jnp.float32)).astype(x.dtype)


def rope(t):
    S = t.shape[1]
    half = HEAD_DIM // 2
    inv_freq = 1.0 / (ROPE_THETA ** (jnp.arange(half, dtype=jnp.float32) / half))
    ang = jnp.arange(S, dtype=jnp.float32)[:, None] * inv_freq[None, :]
    cos = jnp.cos(ang)[None, :, None, :]
    sin = jnp.sin(ang)[None, :, None, :]
    t1, t2 = t[..., :half], t[..., half:]
    return jnp.concatenate([t1 * cos - t2 * sin, t2 * cos + t1 * sin], axis=-1)


def banded_sink_attention(q, k, v, sink):
    B, S = q.shape[0], q.shape[1]
    nb = S // BLOCK
    qb = q.reshape(B, nb, BLOCK, N_KV_HEADS, Q_PER_KV, HEAD_DIM)
    pad = ((0, 0), (BLOCK, BLOCK), (0, 0), (0, 0))

    def bands(t):
        tb = jnp.pad(t, pad).reshape(B, nb + 2, BLOCK, N_KV_HEADS, HEAD_DIM)
        return jnp.concatenate([tb[:, :-2], tb[:, 1:-1], tb[:, 2:]], axis=2)

    kb, vb = bands(k), bands(v)
    s = jnp.einsum('bnqkgd,bnmkd->bnkgqm', qb, kb) * (HEAD_DIM ** -0.5)
    qi = jnp.arange(BLOCK)[:, None]
    mi = jnp.arange(3 * BLOCK)[None, :]
    rel = mi - BLOCK - qi
    key_pos = jnp.arange(nb)[:, None, None] * BLOCK + mi[None] - BLOCK
    valid = (jnp.abs(rel) <= WINDOW)[None] & (key_pos >= 0) & (key_pos < S)
    s = jnp.where(valid[None, :, None, None], s, NEG)
    sink_l = sink.astype(jnp.float32).reshape(N_KV_HEADS, Q_PER_KV)[None, None, :, :, None, None]
    m = jnp.maximum(jnp.max(s, axis=-1, keepdims=True), sink_l)
    p = jnp.exp(s - m)
    denom = jnp.sum(p, axis=-1, keepdims=True) + jnp.exp(sink_l - m)
    o = jnp.einsum('bnkgqm,bnmkd->bnqkgd', p / denom, vb)
    return o.reshape(B, S, ATTN_WIDTH)


def fourier_mix(u, w_lin):
    B, S = u.shape[0], u.shape[1]
    ug = u.astype(jnp.float32).reshape(B, S, N_FOURIER_GROUPS, FOURIER_GROUP_DIM)
    f = jnp.real(jnp.fft.fft2(ug, axes=(1, 3), norm='ortho'))
    out = jnp.einsum('bsgc,gcd->bsgd', f, w_lin.astype(jnp.float32))
    return out.reshape(B, S, FOURIER_WIDTH)


def hybrid_layer(x, g_norm, w_in, q_gain, k_gain, sink, w_four, w_out):
    B, S, _ = x.shape
    h = rms_norm(x, g_norm)
    z = h @ w_in
    q, k, v, g_attn, u, g_four = jnp.split(z, IN_SPLITS, axis=-1)
    q = rms_norm(q.reshape(B, S, N_Q_HEADS, HEAD_DIM), q_gain).astype(jnp.float32)
    k = rms_norm(k.reshape(B, S, N_KV_HEADS, HEAD_DIM), k_gain).astype(jnp.float32)
    v = v.reshape(B, S, N_KV_HEADS, HEAD_DIM).astype(jnp.float32)
    attn = banded_sink_attention(rope(q), rope(k), v, sink).astype(x.dtype)
    four = fourier_mix(u, w_four).astype(x.dtype)
    mixed = jnp.concatenate([jax.nn.silu(g_attn) * attn, jax.nn.silu(g_four) * four], axis=-1)
    return x + mixed @ w_out


def setup_inputs(seed: int = 0) -> dict:
    key = jax.random.key(seed)
    ks = jax.random.split(key, 9)
    f32 = jnp.float32
    x_prompt = jax.random.normal(ks[0], (BATCH, SEQ, D_MODEL), f32)
    x_sample = jax.random.normal(ks[1], (DEC_BATCH, DEC_SEQ, D_MODEL), f32)
    norm_gain = 1.0 + 0.02 * jax.random.normal(ks[2], (DEPTH, D_MODEL), f32)
    w_in = jax.random.normal(ks[3], (DEPTH, D_MODEL, IN_WIDTH), f32) * D_MODEL ** -0.5
    q_norm_gain = 1.0 + 0.02 * jax.random.normal(ks[4], (DEPTH, HEAD_DIM), f32)
    k_norm_gain = 1.0 + 0.02 * jax.random.normal(ks[5], (DEPTH, HEAD_DIM), f32)
    sink_logit = 0.5 * jax.random.normal(ks[6], (DEPTH, N_Q_HEADS), f32)
    w_fourier = jax.random.normal(ks[7], (DEPTH, N_FOURIER_GROUPS, FOURIER_GROUP_DIM, FOURIER_GROUP_DIM), f32) * FOURIER_GROUP_DIM ** -0.5
    w_out = jax.random.normal(ks[8], (DEPTH, MIX_WIDTH, D_MODEL), f32) * MIX_WIDTH ** -0.5
    return {'x_prompt': x_prompt, 'x_sample': x_sample, 'norm_gain': norm_gain, 'w_in': w_in,
            'q_norm_gain': q_norm_gain, 'k_norm_gain': k_norm_gain, 'sink_logit': sink_logit,
            'w_fourier': w_fourier, 'w_out': w_out}


def reference(x_prompt, x_sample, norm_gain, w_in, q_norm_gain, k_norm_gain, sink_logit, w_fourier, w_out):
    y_prompt = x_prompt
    y_sample = x_sample
    for l in range(DEPTH):
        params = (norm_gain[l], w_in[l], q_norm_gain[l], k_norm_gain[l], sink_logit[l], w_fourier[l], w_out[l])
        y_prompt = hybrid_layer(y_prompt, *params)
        y_sample = hybrid_layer(y_sample, *params)
    return (y_prompt, y_sample)
```

```cpp
#include <hip/hip_runtime.h>
#include <cstdio>
#include <cstdint>

#define LAS __attribute__((address_space(3)))
typedef _Float16 f16;
typedef _Float16 f16x8 __attribute__((ext_vector_type(8)));
typedef _Float16 f16x4 __attribute__((ext_vector_type(4)));
typedef _Float16 f16x2 __attribute__((ext_vector_type(2)));
typedef float f32x4 __attribute__((ext_vector_type(4)));
typedef float f32x2 __attribute__((ext_vector_type(2)));
typedef unsigned u32x4 __attribute__((ext_vector_type(4)));
typedef unsigned u32x2 __attribute__((ext_vector_type(2)));

constexpr int SEQ = 4096, NBATCH = 12, MROWS = NBATCH * SEQ  , DM = 1024, INW = 2304, N1 = 2816;
constexpr int ROWS_PROMPT = 4 * SEQ;
constexpr float EPS = 1e-6f;
constexpr float LOG2E = 1.4426950408889634f;
constexpr int NTHREADS = 512;
constexpr int LDS_RS = 152 * 1024 + 256;
constexpr int LDS_BYTES = LDS_RS + 9 * 256 * 2;
constexpr int LDS_MISC = 152 * 1024;
constexpr int LDS_TAB = 128 * 1024;

constexpr size_t SZ_XH = (size_t)MROWS * 1024 * 2, SZ_Q = (size_t)MROWS * 512 * 2, SZ_KV = (size_t)MROWS * 128 * 2;
constexpr size_t WS_XH = 0;
constexpr size_t WS_Q = WS_XH + SZ_XH;
constexpr size_t WS_K = WS_Q + SZ_Q;
constexpr size_t WS_V = WS_K + SZ_KV;
constexpr size_t WS_GA = WS_V + SZ_KV;
constexpr size_t WS_GF = WS_GA + SZ_Q;
constexpr size_t WS_Z = WS_GF + SZ_Q;
constexpr size_t WS_MIX = WS_Z + SZ_XH;
constexpr size_t WS_FOUR = WS_MIX + SZ_XH;
constexpr size_t WS_SS = WS_FOUR + SZ_Q;
constexpr size_t WS_W1T = WS_SS + (size_t)MROWS * 16 * 4;
constexpr size_t WS_W2T = WS_W1T + (size_t)2 * N1 * 1024 * 2;
constexpr size_t WS_MM = WS_W2T + (size_t)2 * 1024 * 1024 * 2;
constexpr size_t WS_ROPE = WS_MM + (size_t)2 * 4 * 128 * 256 * 4;
constexpr size_t WS_TW = WS_ROPE + (size_t)2 * 4096 * 32 * 4;
constexpr size_t WS_ROT = WS_TW + (size_t)4096 * 8;
constexpr size_t WS_BAR = WS_ROT + 1024;
constexpr size_t WS_END = WS_BAR + 16384;

struct Args {
    const float* x_prompt; const float* x_sample; const float* norm_gain; const float* w_in; const float* qgain; const float* kgain;
    const float* sink; const float* w_four; const float* w_out; float* out; unsigned char* ws; int ph_lo, ph_hi;
};

namespace pg8 {
constexpr int BM = 256, BK = 64, HALF = 128, HTB = HALF * BK * 2, STAGE_BYTES = 8 * HTB, NXCD = 8, WGM = 4;
__device__ __forceinline__ int lds_byte(int r, int c) { const int st = (r >> 4) * 2 + (c >> 5), rr = r & 15, cc = c & 31, ob = rr * 64 + cc * 2; return st * 1024 + (ob ^ (((ob >> 9) & 1) << 5)); }
__device__ __forceinline__ void stage_rc(int b, int& R, int& C) { const int st = b / 1024, sb = b % 1024, swz = sb ^ (((sb >> 9) & 1) << 5); R = (st >> 1) * 16 + swz / 64; C = (st & 1) * 32 + (swz % 64) / 2; }
struct Unit { int pm, pn; };
struct Gemm { const f16* A; const f16* Bt; int M, N, K; const f16* A2; };
struct StaticOrder {
    int nM, nN, nwg, G, c, hi;
    __device__ void init(int M, int N, int G_, int c_) { nM = M / BM; nN = N / BM; nwg = nM * nN; G = G_; c = c_; hi = nwg; }
    __device__ bool next(int i, Unit& u) const { const long L = (long)i * G + c; if (L >= hi) return false; unit_of((int)L, u); return true; }
    __device__ void unit_of(int L, Unit& u) const {
        int wgid = L; { const int q = nwg / NXCD, r = nwg % NXCD, xcd = wgid % NXCD, off = wgid / NXCD; wgid = (xcd < r ? xcd * (q + 1) : r * (q + 1) + (xcd - r) * q) + off; }
        const int nig = WGM * nN, gid = wgid / nig, fm = gid * WGM, gsz = (nM - fm) < WGM ? (nM - fm) : WGM;
        u.pm = fm + ((wgid % nig) % gsz); u.pn = (wgid % nig) / gsz;
    }
};

template <class Epi, bool SPLITA>
__device__ __forceinline__ void gemm_phase(LAS unsigned char* lds, const Gemm g, const StaticOrder& S, const Epi& E) {
    int tid_ = threadIdx.x; asm volatile("" : "+v"(tid_));
    const int tid = tid_, wid = __builtin_amdgcn_readfirstlane(tid >> 6), lane = tid & 63, wr = wid >> 2, wc = wid & 3, fr = lane & 15, fq = lane >> 4;
    const int K = g.K, nt = K / BK;
    unsigned voffA[2], voffF[2];
#pragma unroll
    for (int i = 0; i < 2; ++i) { int R, C; stage_rc(tid * 16 + i * 8192, R, C); voffA[i] = (unsigned)(R * K + C) * 2u; voffF[i] = (unsigned)((C >> 3) * 65536 + R * 16); }
    const size_t kstep = (size_t)(BK * 2);
    const size_t hstep = (size_t)HALF * K * 2;
    const size_t tstep = 2 * hstep;
    const unsigned ldsw = (unsigned)wid * 1024u;
    const int aoff = lds_byte(wr * 64 + fr, fq * 8), boff = lds_byte(wc * 32 + fr, fq * 8);
#define PG8_SA(b, h) (((b) * 2 + (h)) * HTB)
#define PG8_SB(b, h) ((4 + (b) * 2 + (h)) * HTB)
#define PG8_STAGE(bufoff, gbase) do { _Pragma("unroll") for (int _i = 0; _i < 2; ++_i) \
        __builtin_amdgcn_global_load_lds((const unsigned*)((const char*)(gbase) + voffA[_i]), (LAS unsigned*)(lds + (bufoff) + ldsw + _i * 8192), 16, 0, 0); } while (0)
#define PG8_STAGE_A(bufoff, pm_, kt_, half_) do { const char* _b; unsigned _v0, _v1; \
        if (SPLITA && (kt_) >= 8) { const int _k2 = (kt_) - 8; _b = (const char*)g.A2 + ((size_t)(((((pm_) >> 4) * 4 + (_k2 >> 1)) * 16 + (_k2 & 1) * 8)) * 4096 + ((pm_) & 15) * 256 + (half_) * 128) * 16; _v0 = voffF[0]; _v1 = voffF[1]; } \
        else { _b = (const char*)g.A + (size_t)(pm_) * tstep + (size_t)(half_) * hstep + (size_t)(kt_) * kstep; _v0 = voffA[0]; _v1 = voffA[1]; } \
        __builtin_amdgcn_global_load_lds((const unsigned*)(_b + _v0), (LAS unsigned*)(lds + (bufoff) + ldsw), 16, 0, 0); \
        __builtin_amdgcn_global_load_lds((const unsigned*)(_b + _v1), (LAS unsigned*)(lds + (bufoff) + ldsw + 8192), 16, 0, 0); } while (0)
#define PG8_LDA(dst, b, h) do { _Pragma("unroll") for (int m = 0; m < 4; ++m) _Pragma("unroll") for (int k = 0; k < 2; ++k) dst[m][k] = *(const LAS f16x8*)(lds + PG8_SA(b, h) + aoff + m * 2048 + k * 1024); } while (0)
#define PG8_LDB(dst, b, h) do { _Pragma("unroll") for (int n = 0; n < 2; ++n) _Pragma("unroll") for (int k = 0; k < 2; ++k) dst[n][k] = *(const LAS f16x8*)(lds + PG8_SB(b, h) + boff + n * 2048 + k * 1024); } while (0)
#define PG8_MMA(ai, bj, At, Bt) do { __builtin_amdgcn_s_setprio(1); _Pragma("unroll") for (int m = 0; m < 4; ++m) _Pragma("unroll") for (int n = 0; n < 2; ++n) _Pragma("unroll") for (int k = 0; k < 2; ++k) \
        acc[ai][bj][m][n] = __builtin_amdgcn_mfma_f32_16x16x32_f16(Bt[n][k], At[m][k], acc[ai][bj][m][n], 0, 0, 0); __builtin_amdgcn_s_setprio(0); } while (0)
#define PG8_WAIT_V(n) asm volatile("s_waitcnt vmcnt(" #n ")" ::: "memory")
#define PG8_WAIT_L(n) asm volatile("s_waitcnt lgkmcnt(" #n ")" ::: "memory")
#define PG8_BAR __builtin_amdgcn_s_barrier()
#define PG8_SCHED __builtin_amdgcn_sched_barrier(0)
    Unit cur, nxt; int ui = 0;
    if (!S.next(0, cur)) return;
    E.prepare(lds, S, tid);
    f32x4 acc[2][2][4][2];
#pragma unroll
    for (int a = 0; a < 2; ++a)
#pragma unroll
        for (int b = 0; b < 2; ++b)
#pragma unroll
            for (int m = 0; m < 4; ++m)
#pragma unroll
                for (int n = 0; n < 2; ++n) acc[a][b][m][n] = (f32x4){0.f, 0.f, 0.f, 0.f};
    f16x8 At[4][2], B0[2][2], B1[2][2];
    const char* cB = (const char*)g.Bt + (size_t)cur.pn * tstep;
    PG8_STAGE(PG8_SB(0, 0), cB); PG8_STAGE(PG8_SB(0, 1), cB + hstep); PG8_STAGE_A(PG8_SA(0, 0), cur.pm, 0, 0); PG8_STAGE_A(PG8_SA(0, 1), cur.pm, 0, 1);
    if (wr == 1) PG8_BAR;
    PG8_WAIT_V(2); PG8_BAR;
    PG8_STAGE(PG8_SB(1, 0), cB + kstep); PG8_STAGE_A(PG8_SA(1, 0), cur.pm, 1, 0); PG8_STAGE(PG8_SB(1, 1), cB + hstep + kstep);
    PG8_WAIT_V(6); PG8_BAR;
    for (;;) {
        const bool has_next = S.next(ui + 1, nxt);
        const int npm = has_next ? nxt.pm : cur.pm; const char* nB = has_next ? (const char*)g.Bt + (size_t)nxt.pn * tstep : cB;
        for (int t = 0; t < nt; t += 2) {
            const bool last = (t == nt - 2);
            const int pm2 = last ? npm : cur.pm, kt2 = last ? 0 : t + 2;
            const char* b2 = last ? nB : cB + (size_t)(t + 2) * kstep; const char* b3 = b2 + kstep;
            PG8_LDB(B0, 0, 0); PG8_LDB(B1, 0, 1); PG8_SCHED; PG8_LDA(At, 0, 0); PG8_STAGE_A(PG8_SA(1, 1), cur.pm, t + 1, 1);
            PG8_WAIT_V(8); PG8_WAIT_L(0); PG8_BAR; PG8_MMA(0, 0, At, B0); PG8_MMA(0, 1, At, B1); PG8_BAR; PG8_SCHED;
            PG8_LDA(At, 0, 1); PG8_STAGE(PG8_SB(0, 0), b2); PG8_STAGE(PG8_SB(0, 1), b2 + hstep); PG8_STAGE_A(PG8_SA(0, 0), pm2, kt2, 0);
            PG8_WAIT_V(8); PG8_WAIT_L(0); PG8_BAR; PG8_MMA(1, 0, At, B0); PG8_MMA(1, 1, At, B1); PG8_BAR; PG8_SCHED;
            PG8_LDB(B0, 1, 0); PG8_LDB(B1, 1, 1); PG8_SCHED; PG8_LDA(At, 1, 0); PG8_STAGE_A(PG8_SA(0, 1), pm2, kt2, 1);
            PG8_WAIT_V(8); PG8_WAIT_L(0); PG8_BAR; PG8_MMA(0, 0, At, B0); PG8_MMA(0, 1, At, B1); PG8_BAR; PG8_SCHED;
            PG8_LDA(At, 1, 1); PG8_STAGE(PG8_SB(1, 0), b3); PG8_STAGE(PG8_SB(1, 1), b3 + hstep); PG8_STAGE_A(PG8_SA(1, 0), pm2, kt2 + 1, 0);
            PG8_WAIT_V(8); PG8_WAIT_L(0); PG8_BAR; PG8_MMA(1, 0, At, B0); PG8_MMA(1, 1, At, B1); PG8_BAR; PG8_SCHED;
        }
        if (wr == 0) PG8_BAR;
        E(acc, cur, ui, lds, wr, wc, fr, fq);
        if (!has_next) break;
#pragma unroll
        for (int a = 0; a < 2; ++a)
#pragma unroll
            for (int b = 0; b < 2; ++b)
#pragma unroll
                for (int m = 0; m < 4; ++m)
#pragma unroll
                    for (int n = 0; n < 2; ++n) acc[a][b][m][n] = (f32x4){0.f, 0.f, 0.f, 0.f};
        cur = nxt; cB = nB; ++ui;
        if (wr == 1) PG8_BAR;
    }
    PG8_WAIT_V(0);
    PG8_BAR;
#undef PG8_SA
#undef PG8_SB
#undef PG8_STAGE
#undef PG8_STAGE_A
#undef PG8_LDA
#undef PG8_LDB
#undef PG8_MMA
#undef PG8_WAIT_V
#undef PG8_WAIT_L
#undef PG8_BAR
#undef PG8_SCHED
}
}

__host__ __device__ __forceinline__ int colmap(int rho) { const int bj = rho >> 7, wc = (rho >> 5) & 3, n = (rho >> 4) & 1, fq = (rho >> 2) & 3, j = rho & 3; return 64 * wc + 32 * bj + 8 * fq + 4 * n + j; }

__device__ __forceinline__ float silu_f(float z) { return z * __builtin_amdgcn_rcpf(1.0f + __builtin_amdgcn_exp2f(-LOG2E * z)); }
__device__ __forceinline__ u32x4 pack8(const float* v) {
    f16x8 h;
#pragma unroll
    for (int i = 0; i < 8; ++i) h[i] = (f16)v[i];
    return __builtin_bit_cast(u32x4, h);
}

__device__ __forceinline__ void gemm1_tail_quadrant(LAS unsigned char* lds, const f16* A, const f16* Bt, unsigned char* ws, int pm, int pn, int ai, int bj) {
    using namespace pg8;
    int tid_ = threadIdx.x; asm volatile("" : "+v"(tid_));
    const int tid = tid_, wid = __builtin_amdgcn_readfirstlane(tid >> 6), lane = tid & 63, wr = wid >> 2, wc = wid & 3, fr = lane & 15, fq = lane >> 4;
    constexpr int K = 1024, NT = K / BK;
    unsigned voff[2];
#pragma unroll
    for (int i = 0; i < 2; ++i) { int R, C; stage_rc(tid * 16 + i * 8192, R, C); voff[i] = (unsigned)(R * K + C) * 2u; }
    const char* abase = (const char*)A + ((size_t)pm * 256 + ai * 128) * K * 2;
    const char* bbase = (const char*)Bt + ((size_t)pn * 256 + bj * 128) * K * 2;
    const unsigned ldsw = (unsigned)wid * 1024u;
    const int aoff = lds_byte(wr * 64 + fr, fq * 8), boff = lds_byte(wc * 32 + fr, fq * 8);
#define QSTAGE(s_, kt_) do { _Pragma("unroll") for (int _i = 0; _i < 2; ++_i) { \
        __builtin_amdgcn_global_load_lds((const unsigned*)(abase + (size_t)(kt_) * (BK * 2) + voff[_i]), (LAS unsigned*)(lds + (s_) * 32768 + ldsw + _i * 8192), 16, 0, 0); \
        __builtin_amdgcn_global_load_lds((const unsigned*)(bbase + (size_t)(kt_) * (BK * 2) + voff[_i]), (LAS unsigned*)(lds + (s_) * 32768 + 16384 + ldsw + _i * 8192), 16, 0, 0); } } while (0)
    f32x4 acc[4][2];
#pragma unroll
    for (int m = 0; m < 4; ++m)
#pragma unroll
        for (int n = 0; n < 2; ++n) acc[m][n] = (f32x4){0.f, 0.f, 0.f, 0.f};
    QSTAGE(0, 0); QSTAGE(1, 1); QSTAGE(2, 2);
#pragma unroll 1
    for (int t = 0; t < NT; ++t) {
        if (t <= NT - 3) asm volatile("s_waitcnt vmcnt(8)" ::: "memory"); else if (t == NT - 2) asm volatile("s_waitcnt vmcnt(4)" ::: "memory"); else asm volatile("s_waitcnt vmcnt(0)" ::: "memory");
        __builtin_amdgcn_s_barrier();
        if (t + 3 < NT) QSTAGE((t + 3) & 3, t + 3);
        LAS unsigned char* sl = lds + (t & 3) * 32768;
        f16x8 At[4][2], Bf[2][2];
#pragma unroll
        for (int m = 0; m < 4; ++m)
#pragma unroll
            for (int k = 0; k < 2; ++k) At[m][k] = *(const LAS f16x8*)(sl + aoff + m * 2048 + k * 1024);
#pragma unroll
        for (int n = 0; n < 2; ++n)
#pragma unroll
            for (int k = 0; k < 2; ++k) Bf[n][k] = *(const LAS f16x8*)(sl + 16384 + boff + n * 2048 + k * 1024);
#pragma unroll
        for (int m = 0; m < 4; ++m)
#pragma unroll
            for (int n = 0; n < 2; ++n)
#pragma unroll
                for (int k = 0; k < 2; ++k) acc[m][n] = __builtin_amdgcn_mfma_f32_16x16x32_f16(Bf[n][k], At[m][k], acc[m][n], 0, 0, 0);
    }
#undef QSTAGE
    const float* SS = (const float*)(ws + WS_SS); f16* Z = (f16*)(ws + WS_Z);
    const int row0 = pm * 256 + ai * 128 + wr * 64 + fr;
    f32x4 part[4];
#pragma unroll
    for (int m = 0; m < 4; ++m) part[m] = *(const f32x4*)(SS + (size_t)(row0 + m * 16) * 16 + 4 * fq);
#pragma unroll
    for (int m = 0; m < 4; ++m) {
        float t = (part[m][0] + part[m][1]) + (part[m][2] + part[m][3]);
        t += __shfl_xor(t, 16); t += __shfl_xor(t, 32);
        const float rs = __builtin_amdgcn_rsqf(t * (1.0f / 1024.0f) + EPS);
        const int row = row0 + m * 16;
        float v[8];
#pragma unroll
        for (int e = 0; e < 8; ++e) v[e] = acc[m][e >> 2][e & 3] * rs;
        const int cg8 = 8 * (wc & 1) + 4 * bj + fq;
        f16* p = Z + (((size_t)(((row >> 12) * 4 + (pn - 7)) * 16 + cg8) * 4096 + (row & 4095)) * 2 + (wc >> 1)) * 8;
        *(u32x4*)p = pack8(v);
    }
    asm volatile("s_waitcnt vmcnt(0)" ::: "memory");
    __syncthreads();
}

struct Epi1 {
    unsigned char* __restrict__ ws; const float* __restrict__ qg; const float* __restrict__ kg;
    __device__ __forceinline__ void prepare(LAS unsigned char* lds, const pg8::StaticOrder& S, int tid) const {
        const float* SS = (const float*)(ws + WS_SS);
        f32x4 p0[9], p1[9];
#pragma unroll
        for (int i = 0; i < 9; ++i) {
            pg8::Unit u; p0[i] = (f32x4){0.f, 0.f, 0.f, 0.f}; p1[i] = p0[i];
            if (S.next(i, u)) { const float* sp = SS + (size_t)(u.pm * 256 + (tid >> 1)) * 16 + (tid & 1) * 8; p0[i] = *(const f32x4*)sp; p1[i] = *(const f32x4*)(sp + 4); }
        }
#pragma unroll
        for (int i = 0; i < 9; ++i) {
            float t = ((p0[i][0] + p0[i][1]) + (p0[i][2] + p0[i][3])) + ((p1[i][0] + p1[i][1]) + (p1[i][2] + p1[i][3]));
            t += __shfl_xor(t, 1);
            if ((tid & 1) == 0) ((LAS f16*)(lds + LDS_RS))[i * 256 + (tid >> 1)] = (f16)(1.0f / sqrtf(t * (1.0f / 1024.0f) + EPS));
        }
        __syncthreads();
    }
    __device__ __forceinline__ void operator()(const f32x4 (&acc)[2][2][4][2], const pg8::Unit& u, int ui, LAS unsigned char* lds, int wr, int wc, int fr_, int fq_) const {
        int fr = fr_, fq = fq_; asm volatile("" : "+v"(fr), "+v"(fq));
        const float* ropeC = (const float*)(ws + WS_ROPE); const float* ropeS = ropeC + 4096 * 32; const float* rot = (const float*)(ws + WS_ROT);
        f16* Q = (f16*)(ws + WS_Q); f16* K = (f16*)(ws + WS_K); f16* V = (f16*)(ws + WS_V); f16* GA = (f16*)(ws + WS_GA); f16* GF = (f16*)(ws + WS_GF); f16* Z = (f16*)(ws + WS_Z);
        const int pn = u.pn;
        const bool is_qk = (pn <= 1) || (pn == 2 && wc < 2);
        const int row0 = u.pm * 256 + wr * 64 + fr;
        float rsv[8];
#pragma unroll
        for (int i = 0; i < 8; ++i) rsv[i] = (float)((const LAS f16*)(lds + LDS_RS))[ui * 256 + wr * 64 + fr + (i >> 2) * 128 + (i & 3) * 16];
        if (is_qk) {
            const float* gain = (pn <= 1) ? qg : kg;
            const float oscale = (pn <= 1) ? (0.125f * LOG2E) : 1.0f;
            f32x4 gv[2][2];
#pragma unroll
            for (int bj = 0; bj < 2; ++bj)
#pragma unroll
                for (int n = 0; n < 2; ++n) gv[bj][n] = *(const f32x4*)(gain + 32 * bj + 8 * fq + 4 * n);
            const int pos0 = row0 & (SEQ - 1);
            f32x4 cs[2], sn[2], c16[2], s16[2];
#pragma unroll
            for (int n = 0; n < 2; ++n) {
                cs[n] = *(const f32x4*)(ropeC + pos0 * 32 + 8 * fq + 4 * n); sn[n] = *(const f32x4*)(ropeS + pos0 * 32 + 8 * fq + 4 * n);
                c16[n] = *(const f32x4*)(rot + 8 * fq + 4 * n); s16[n] = *(const f32x4*)(rot + 32 + 8 * fq + 4 * n);
            }
#pragma unroll
            for (int ai = 0; ai < 2; ++ai) {
                if (ai == 1) {
#pragma unroll
                    for (int k = 0; k < 5; ++k)
#pragma unroll
                        for (int n = 0; n < 2; ++n) { const f32x4 c2 = cs[n] * c16[n] - sn[n] * s16[n]; sn[n] = sn[n] * c16[n] + cs[n] * s16[n]; cs[n] = c2; }
                }
#pragma unroll
                for (int m = 0; m < 4; ++m) {
                    const int row = row0 + ai * 128 + m * 16;
                    const float rs = rsv[ai * 4 + m];
                    float v[2][8];
#pragma unroll
                    for (int bj = 0; bj < 2; ++bj)
#pragma unroll
                        for (int e = 0; e < 8; ++e) v[bj][e] = acc[ai][bj][m][e >> 2][e & 3] * rs;
                    float ss = 0.f;
#pragma unroll
                    for (int bj = 0; bj < 2; ++bj)
#pragma unroll
                        for (int e = 0; e < 8; ++e) ss += v[bj][e] * v[bj][e];
                    ss += __shfl_xor(ss, 16); ss += __shfl_xor(ss, 32);
                    const float rn = __builtin_amdgcn_rsqf(ss * (1.0f / 64.0f) + EPS);
                    float o0[8], o1[8];
#pragma unroll
                    for (int e = 0; e < 8; ++e) {
                        const float cc = cs[e >> 2][e & 3], sv = sn[e >> 2][e & 3];
                        const float q0 = v[0][e] * rn * gv[0][e >> 2][e & 3], q1 = v[1][e] * rn * gv[1][e >> 2][e & 3];
                        o0[e] = (q0 * cc - q1 * sv) * oscale; o1[e] = (q1 * cc + q0 * sv) * oscale;
                    }
                    f16* p = (pn <= 1) ? Q + (size_t)row * 512 + (pn * 4 + wc) * 64 + 8 * fq : K + (size_t)row * 128 + wc * 64 + 8 * fq;
                    *(u32x4*)p = pack8(o0); *(u32x4*)(p + 32) = pack8(o1);
                    if (m < 3) {
#pragma unroll
                        for (int n = 0; n < 2; ++n) { const f32x4 c2 = cs[n] * c16[n] - sn[n] * s16[n]; sn[n] = sn[n] * c16[n] + cs[n] * s16[n]; cs[n] = c2; }
                    }
                }
            }
        } else {
#pragma unroll
            for (int ai = 0; ai < 2; ++ai)
#pragma unroll
                for (int m = 0; m < 4; ++m) {
                    const int row = row0 + ai * 128 + m * 16;
                    const float rs = rsv[ai * 4 + m];
                    float v[2][8];
#pragma unroll
                    for (int bj = 0; bj < 2; ++bj)
#pragma unroll
                        for (int e = 0; e < 8; ++e) v[bj][e] = acc[ai][bj][m][e >> 2][e & 3] * rs;
                    if (pn == 2) {
                        f16* p = V + (size_t)row * 128 + (wc - 2) * 64 + 8 * fq; *(u32x4*)p = pack8(v[0]); *(u32x4*)(p + 32) = pack8(v[1]);
                    } else if (pn <= 4) {
#pragma unroll
                        for (int bj = 0; bj < 2; ++bj)
#pragma unroll
                            for (int e = 0; e < 8; ++e) v[bj][e] = silu_f(v[bj][e]);
                        f16* p = GA + (size_t)row * 512 + (pn - 3) * 256 + wc * 64 + 8 * fq;
                        *(u32x4*)p = pack8(v[0]); *(u32x4*)(p + 32) = pack8(v[1]);
                    } else if (pn <= 6) {
#pragma unroll
                        for (int bj = 0; bj < 2; ++bj)
#pragma unroll
                            for (int e = 0; e < 8; ++e) v[bj][e] = silu_f(v[bj][e]);
                        const int gq = 2 * (pn - 5) + (wc >> 1), cg8 = 8 * (wc & 1) + fq;
                        f16* p = GF + ((size_t)(((row >> 12) * 4 + gq) * 16 + cg8) * 4096 + (row & 4095)) * 8;
                        *(u32x4*)p = pack8(v[0]); *(u32x4*)(p + (size_t)4 * 4096 * 8) = pack8(v[1]);
                    } else {
                        const int cg8 = 8 * (wc & 1) + fq;
                        f16* p = Z + (((size_t)(((row >> 12) * 4 + (pn - 7)) * 16 + cg8) * 4096 + (row & 4095)) * 2 + (wc >> 1)) * 8;
                        *(u32x4*)p = pack8(v[0]); *(u32x4*)(p + (size_t)4 * 4096 * 16) = pack8(v[1]);
                    }
                }
        }
    }
};

struct Epi2 {
    const float* __restrict__ xp; const float* __restrict__ xs; float* __restrict__ out; f16* XH; float* __restrict__ SS; int layer;
    __device__ __forceinline__ void prepare(LAS unsigned char*, const pg8::StaticOrder&, int) const {}
    __device__ __forceinline__ void operator()(const f32x4 (&acc)[2][2][4][2], const pg8::Unit& u, int, LAS unsigned char*, int wr, int wc, int fr_, int fq_) const {
        int fr = fr_, fq = fq_; asm volatile("" : "+v"(fr), "+v"(fq));
        const int row0 = u.pm * 256 + wr * 64 + fr, col0 = u.pn * 256 + wc * 64 + 8 * fq;
        if (layer == 0) {
#pragma unroll
            for (int ai = 0; ai < 2; ++ai) {
                f16x8 xh[4][2];
#pragma unroll
                for (int m = 0; m < 4; ++m)
#pragma unroll
                    for (int bj = 0; bj < 2; ++bj) xh[m][bj] = *(const f16x8*)(XH + (size_t)(row0 + ai * 128 + m * 16) * DM + col0 + bj * 32);
#pragma unroll
                for (int m = 0; m < 4; ++m) {
                    const int row = row0 + ai * 128 + m * 16;
                    float ss = 0.f;
#pragma unroll
                    for (int bj = 0; bj < 2; ++bj) {
                        f16x8 hv;
#pragma unroll
                        for (int e = 0; e < 8; ++e) { hv[e] = (f16)((float)xh[m][bj][e] + acc[ai][bj][m][e >> 2][e & 3]); const float tr = (float)hv[e]; ss += tr * tr; }
                        *(f16x8*)(XH + (size_t)row * DM + col0 + bj * 32) = hv;
                    }
                    ss += __shfl_xor(ss, 16); ss += __shfl_xor(ss, 32);
                    if (fq == 0) SS[(size_t)row * 16 + u.pn * 4 + wc] = ss;
                }
            }
        } else {
            f16x8 xh[2][4][2];
#pragma unroll
            for (int ai = 0; ai < 2; ++ai)
#pragma unroll
                for (int m = 0; m < 4; ++m)
#pragma unroll
                    for (int bj = 0; bj < 2; ++bj) xh[ai][m][bj] = *(const f16x8*)(XH + (size_t)(row0 + ai * 128 + m * 16) * DM + col0 + bj * 32);
#pragma unroll
            for (int ai = 0; ai < 2; ++ai)
#pragma unroll
                for (int m = 0; m < 4; ++m) {
                    float* dst = out + (size_t)(row0 + ai * 128 + m * 16) * DM + col0;
#pragma unroll
                    for (int bj = 0; bj < 2; ++bj) {
                        f32x4 x0, x1;
#pragma unroll
                        for (int e = 0; e < 4; ++e) { x0[e] = (float)xh[ai][m][bj][e] + acc[ai][bj][m][0][e]; x1[e] = (float)xh[ai][m][bj][4 + e] + acc[ai][bj][m][1][e]; }
                        *(f32x4*)(dst + bj * 32) = x0; *(f32x4*)(dst + bj * 32 + 4) = x1;
                    }
                }
        }
    }
};

__device__ void p0_mmat(const Args& a, LAS unsigned char* lds) {
    LAS float* ct = (LAS float*)lds; LAS float* st = ct + 128;
    int tid_ = threadIdx.x; asm volatile("" : "+v"(tid_)); const int tid = tid_;
    if (tid < 128) { float s, c; sincospif((float)tid * (1.0f / 64.0f), &s, &c); ct[tid] = c; st[tid] = s; }
    __syncthreads();
    float* MM = (float*)(a.ws + WS_MM);
    const int total = 2 * 4 * 128 * 64;
    for (int idx = blockIdx.x * NTHREADS + tid; idx < total; idx += gridDim.x * NTHREADS) {
        const int d4 = idx & 63, cp = (idx >> 6) & 127, lg = idx >> 13;
        const float* W = a.w_four + (size_t)lg * 128 * 128 + 4 * (d4 & 31);
        const LAS float* tb = (d4 < 32) ? ct : st;
        f32x4 acc = {0.f, 0.f, 0.f, 0.f};
#pragma unroll 8
        for (int c = 0; c < 128; ++c) acc += *(const f32x4*)(W + c * 128) * tb[(cp * c) & 127];
        *(f32x4*)(MM + ((size_t)(lg * 128 + cp) * 256 + 4 * d4)) = acc * 0.08838834764831845f;
    }
    __syncthreads();
}
__device__ void p0_rope(const Args& a) {
    float* rc = (float*)(a.ws + WS_ROPE); float* rsn = rc + 4096 * 32;
    for (int idx = blockIdx.x * NTHREADS + threadIdx.x; idx < 4096 * 32; idx += gridDim.x * NTHREADS) {
        const int i = idx & 31, pos = idx >> 5;
        const float inv_freq = 1.0f / powf(10000.0f, (float)i * (1.0f / 32.0f));
        const float ang = (float)pos * inv_freq;
        float s, c; sincosf(ang, &s, &c);
        rc[idx] = c; rsn[idx] = s;
    }
    if (blockIdx.x == 0 && threadIdx.x < 64) {
        float* rot = (float*)(a.ws + WS_ROT);
        const int i = threadIdx.x & 31, step = (threadIdx.x < 32) ? 16 : 128;
        const float inv_freq = 1.0f / powf(10000.0f, (float)i * (1.0f / 32.0f));
        float s, c; sincosf((float)step * inv_freq, &s, &c);
        rot[(threadIdx.x < 32 ? 0 : 64) + i] = c; rot[(threadIdx.x < 32 ? 32 : 96) + i] = s;
    }
}
__device__ void p0_xconv(const Args& a) {
    f16* XH = (f16*)(a.ws + WS_XH); float* SS = (float*)(a.ws + WS_SS);
    int tid_ = threadIdx.x; asm volatile("" : "+v"(tid_));
    const int lane = tid_ & 63, wv = tid_ >> 6;
    const int nwv = (int)gridDim.x * 8;
    for (int row0 = (int)blockIdx.x * 8 + wv; row0 < MROWS; row0 += 4 * nwv) {
        f32x4 v[4][4];
#pragma unroll
        for (int r = 0; r < 4; ++r) {
            const int row = row0 + r * nwv;
            if (row < MROWS) {
                const float* src = (row < ROWS_PROMPT) ? a.x_prompt + (size_t)row * DM : a.x_sample + (size_t)(row - ROWS_PROMPT) * DM;
#pragma unroll
                for (int i = 0; i < 4; ++i) v[r][i] = __builtin_nontemporal_load((const f32x4*)(src + i * 256 + lane * 4));
            }
        }
#pragma unroll
        for (int r = 0; r < 4; ++r) {
            const int row = row0 + r * nwv;
            if (row < MROWS) {
                float ss = 0.f;
#pragma unroll
                for (int i = 0; i < 4; ++i) {
                    const f32x4 x = v[r][i];
                    ss += (x[0] * x[0] + x[1] * x[1]) + (x[2] * x[2] + x[3] * x[3]);
                    f16x4 h; h[0] = (f16)x[0]; h[1] = (f16)x[1]; h[2] = (f16)x[2]; h[3] = (f16)x[3];
                    *(f16x4*)(XH + (size_t)row * DM + i * 256 + lane * 4) = h;
                }
#pragma unroll
                for (int o = 1; o < 64; o <<= 1) ss += __shfl_xor(ss, o);
                if (lane < 16) SS[(size_t)row * 16 + lane] = (lane == 0) ? ss : 0.f;
            }
        }
    }
}
__device__ void p_weights_plain(const Args& a) {
    int tid_ = threadIdx.x; asm volatile("" : "+v"(tid_)); const int tid = tid_;
    const int cq = tid & 63, rq = tid >> 6;
    const int lc0 = 4 * cq;
    const int rho0 = 128 * ((lc0 >> 5) & 1) + 32 * (lc0 >> 6) + 16 * ((lc0 >> 2) & 1) + 4 * ((lc0 >> 3) & 3);
    f16* W1T = (f16*)(a.ws + WS_W1T); f16* W2T = (f16*)(a.ws + WS_W2T);
    for (int u = blockIdx.x; u < 704; u += gridDim.x) {
        const float* w; f16* dst; int ldw, col; f32x4 gn = {1.f, 1.f, 1.f, 1.f};
        if (u < 448) {
            const int l = u / 224, r = u % 224, pn = r >> 5, kblk = r & 31, k0 = kblk * 32 + 4 * rq;
            const int L = pn * 256 + lc0; col = (L < 1280) ? L : L + 512; ldw = INW;
            w = a.w_in + (size_t)l * DM * INW + (size_t)k0 * INW;
            gn = *(const f32x4*)(a.norm_gain + l * DM + k0);
            dst = W1T + ((size_t)l * N1 + pn * 256 + rho0) * 1024 + k0;
        } else {
            const int r = u - 448, l = r >> 7, pn = (r >> 5) & 3, kblk = r & 31, k0 = kblk * 32 + 4 * rq;
            col = pn * 256 + lc0; ldw = DM;
            w = a.w_out + (size_t)l * DM * DM + (size_t)k0 * DM;
            dst = W2T + ((size_t)l * DM + pn * 256 + rho0) * 1024 + k0;
        }
        f32x4 x[4];
#pragma unroll
        for (int i = 0; i < 4; ++i) x[i] = __builtin_nontemporal_load((const f32x4*)(w + (size_t)i * ldw + col)) * gn[i];
#pragma unroll
        for (int j = 0; j < 4; ++j) {
            f16x4 o;
#pragma unroll
            for (int i = 0; i < 4; ++i) o[i] = (f16)x[i][j];
            *(f16x4*)(dst + (size_t)j * 1024) = o;
        }
    }
}
__device__ void p_weights_prod(const Args& a, LAS unsigned char* lds) {
    int tid_ = threadIdx.x; asm volatile("" : "+v"(tid_)); const int tid = tid_;
    const int cq = tid & 63, rq = tid >> 6;
    const int lc0 = 4 * cq;
    const int rho0 = 128 * ((lc0 >> 5) & 1) + 32 * (lc0 >> 6) + 16 * ((lc0 >> 2) & 1) + 4 * ((lc0 >> 3) & 3);
    f16* W1T = (f16*)(a.ws + WS_W1T); const float* MM = (const float*)(a.ws + WS_MM);
    LAS float* wt = (LAS float*)lds;
    LAS float* mmt = (LAS float*)(lds + 16384);
    for (int u = blockIdx.x; u < 256; u += gridDim.x) {
        const int l = u >> 7, g = (u >> 5) & 3, kblk = u & 31, pn = 7 + g;
        __syncthreads();
        {
            const int rr = tid >> 4, c8 = (tid & 15) * 8;
            const float* src = a.w_in + (size_t)l * DM * INW + (size_t)(kblk * 32 + rr) * INW + 1280 + g * 128 + c8;
            const f32x4* msrc = (const f32x4*)(MM + (size_t)(l * 4 + g) * 128 * 256) + tid;
            f32x4 mreg[16];
#pragma unroll
            for (int j = 0; j < 16; ++j) mreg[j] = msrc[j * NTHREADS];
            *(LAS f32x4*)(wt + rr * 128 + c8) = *(const f32x4*)src; *(LAS f32x4*)(wt + rr * 128 + c8 + 4) = *(const f32x4*)(src + 4);
#pragma unroll
            for (int j = 0; j < 16; ++j) ((LAS f32x4*)mmt)[tid + j * NTHREADS] = mreg[j];
        }
        __syncthreads();
        f32x4 acc[4];
#pragma unroll
        for (int r2 = 0; r2 < 4; ++r2) acc[r2] = (f32x4){0.f, 0.f, 0.f, 0.f};
#pragma unroll 2
        for (int c0 = 0; c0 < 128; c0 += 4) {
            f32x4 w4[4], m4[4];
#pragma unroll
            for (int r2 = 0; r2 < 4; ++r2) w4[r2] = *(const LAS f32x4*)(wt + (4 * rq + r2) * 128 + c0);
#pragma unroll
            for (int cc = 0; cc < 4; ++cc) m4[cc] = *(const LAS f32x4*)(mmt + (c0 + cc) * 256 + lc0);
#pragma unroll
            for (int r2 = 0; r2 < 4; ++r2)
#pragma unroll
                for (int cc = 0; cc < 4; ++cc) acc[r2] += m4[cc] * w4[r2][cc];
        }
        const int k0 = kblk * 32 + 4 * rq;
        const f32x4 gn = *(const f32x4*)(a.norm_gain + l * DM + k0);
#pragma unroll
        for (int j = 0; j < 4; ++j) {
            f16x4 o;
#pragma unroll
            for (int r2 = 0; r2 < 4; ++r2) o[r2] = (f16)(acc[r2][j] * gn[r2]);
            *(f16x4*)(W1T + ((size_t)l * N1 + pn * 256 + rho0 + j) * 1024 + k0) = o;
        }
    }
    __syncthreads();
}

typedef float f32x16 __attribute__((ext_vector_type(16)));
typedef short s16x4 __attribute__((ext_vector_type(4)));
__device__ __forceinline__ f16x8 tr_pair(LAS unsigned char* p0, LAS unsigned char* p1) {
    const s16x4 lo = __builtin_amdgcn_ds_read_tr16_b64_v4i16((LAS s16x4*)p0);
    const s16x4 hi = __builtin_amdgcn_ds_read_tr16_b64_v4i16((LAS s16x4*)p1);
    return __builtin_bit_cast(f16x8, __builtin_shufflevector(lo, hi, 0, 1, 2, 3, 4, 5, 6, 7));
}
__device__ __forceinline__ float max3f(float a, float b, float c) { float d; asm("v_max3_f32 %0, %1, %2, %3" : "=v"(d) : "v"(a), "v"(b), "v"(c)); return d; }
__device__ __forceinline__ f16x8 pack_p(const f32x16& p, int s) {
    f16x8 r;
#pragma unroll
    for (int j = 0; j < 8; ++j) r[j] = (f16)p[8 * s + j];
    return r;
}
__device__ void attn_phase(const Args& a, LAS unsigned char* lds, int layer) {
    int tid_ = threadIdx.x; asm volatile("" : "+v"(tid_)); const int tid = tid_;
    const int lane = tid & 63, wid = __builtin_amdgcn_readfirstlane(tid >> 6), r = lane & 31, h = lane >> 5;
    const int hq = wid >> 1, qh = wid & 1;
    const f16* Q = (const f16*)(a.ws + WS_Q); const f16* K = (const f16*)(a.ws + WS_K); const f16* V = (const f16*)(a.ws + WS_V);
    const f16* GA = (const f16*)(a.ws + WS_GA); f16* MIX = (f16*)(a.ws + WS_MIX);
    const int G = gridDim.x;
    int unit = blockIdx.x;
    if (unit >= 1536) return;
    float m0;
    {
        float gq = fabsf(a.qgain[layer * 64 + lane]), gk = fabsf(a.kgain[layer * 64 + lane]);
#pragma unroll
        for (int o = 1; o < 64; o <<= 1) { gq = fmaxf(gq, __shfl_xor(gq, o)); gk = fmaxf(gk, __shfl_xor(gk, o)); }
        m0 = __builtin_bit_cast(float, __builtin_amdgcn_readfirstlane(__builtin_bit_cast(int, 8.0f * gq * gk * LOG2E - 8.0f)));
    }
    u32x4 kreg[5], vreg[5];
#define ATT_LOAD(un) do { const int _qb = (un) & 63, _kvh = ((un) >> 6) & 1, _b = (un) >> 7, _q0 = _qb * 64; \
        _Pragma("unroll") for (int j = 0; j < 5; ++j) { const int i = tid + NTHREADS * j, rr = i >> 3, c = i & 7, kp = _q0 - 128 + rr; \
            kreg[j] = (u32x4){0u, 0u, 0u, 0u}; vreg[j] = (u32x4){0u, 0u, 0u, 0u}; \
            if (kp >= 0 && kp < SEQ) { const size_t off = ((size_t)(_b * SEQ + kp)) * 128 + _kvh * 64 + c * 8; kreg[j] = *(const u32x4*)(K + off); vreg[j] = *(const u32x4*)(V + off); } } \
        } while (0)
    ATT_LOAD(unit);
    const int blk = (lane >> 4) & 1, tq = (lane & 15) >> 2, tp = lane & 3;
#pragma unroll 1
    for (; unit < 1536; unit += G) {
        const int qb = unit & 63, kvh = (unit >> 6) & 1, b = unit >> 7, q0 = qb * 64;
        const int head = kvh * 4 + hq, qp = q0 + 32 * qh + r;
        const size_t grow = (size_t)(b * SEQ + qp);
        f16x8 qf[4];
#pragma unroll
        for (int s = 0; s < 4; ++s) qf[s] = *(const f16x8*)(Q + grow * 512 + head * 64 + 16 * s + 8 * h);
        const float sinkv = a.sink[layer * 8 + head];
        __syncthreads();
#pragma unroll
        for (int j = 0; j < 5; ++j) {
            const int i = tid + NTHREADS * j, rr = i >> 3, c = i & 7;
            *(LAS u32x4*)(lds + rr * 128 + ((c ^ ((rr >> 1) & 7)) << 4)) = kreg[j];
            *(LAS u32x4*)(lds + 40960 + rr * 128 + (((c >> 1) ^ (rr & 3)) << 5) + ((c & 1) << 4)) = vreg[j];
        }
        __syncthreads();
        if (unit + G < 1536) ATT_LOAD(unit + G);
        f32x16 O0, O1;
#pragma unroll
        for (int i = 0; i < 16; ++i) { O0[i] = 0.f; O1[i] = 0.f; }
        float l = h ? 0.0f : __builtin_amdgcn_exp2f(sinkv * LOG2E - m0);
        const int lo_d = (-qp > -128) ? -qp : -128, hi_d = (SEQ - 1 - qp < 128) ? (SEQ - 1 - qp) : 128;
        const int ksw = (r >> 1) & 7;
        LAS unsigned char* kbase = lds + r * 128 + qh * 4096;
        LAS unsigned char* vbase = lds + 40960 + (4 * h + tq) * 128 + tp * 8 + qh * 4096;
        const int vsw0 = ((0 + blk) ^ tq) << 5, vsw1 = ((2 + blk) ^ tq) << 5;
        const int dbase = q0 - 128 + 32 * qh + 4 * h - qp;
        f16x8 kf[4];
#define ATT_KREAD(j_) do { _Pragma("unroll") for (int s = 0; s < 4; ++s) kf[s] = *(const LAS f16x8*)(kbase + (j_) * 4096 + (((2 * s + h) ^ ksw) << 4)); } while (0)
        f32x16 A;
#pragma unroll
        for (int i = 0; i < 16; ++i) A[i] = -m0;
        ATT_KREAD(0);
#pragma unroll
        for (int s = 0; s < 4; ++s) A = __builtin_amdgcn_mfma_f32_32x32x16_f16(kf[s], qf[s], A, 0, 0, 0);
        u32x4 gw[2][2];
#pragma unroll 1
        for (int j = 0; j < 9; ++j) {
            f32x16 S = A;
            if (j < 8) ATT_KREAD(j + 1);
            f16x8 vf[2][2];
#pragma unroll
            for (int sp = 0; sp < 2; ++sp) {
                LAS unsigned char* va = vbase + (32 * j + 16 * sp) * 128;
                vf[sp][0] = tr_pair(va + vsw0, va + 1024 + vsw0);
                vf[sp][1] = tr_pair(va + vsw1, va + 1024 + vsw1);
            }
            __builtin_amdgcn_sched_barrier(0);
            if (j < 8) {
#pragma unroll
                for (int i = 0; i < 16; ++i) A[i] = -m0;
#pragma unroll
                for (int s = 0; s < 4; ++s) A = __builtin_amdgcn_mfma_f32_32x32x16_f16(kf[s], qf[s], A, 0, 0, 0);
            }
            if (j == 7) {
#pragma unroll
                for (int dt = 0; dt < 2; ++dt)
#pragma unroll
                    for (int kk = 0; kk < 2; ++kk) gw[dt][kk] = *(const u32x4*)(GA + grow * 512 + head * 64 + 32 * dt + 8 * (2 * kk + h));
            }
            __builtin_amdgcn_sched_barrier(0);
            const int k0s = q0 - 128 + 32 * (qh + j);
            if (j == 0 || j == 8 || k0s < 0 || k0s + 32 > SEQ) {
                const int base = dbase + 32 * j;
#pragma unroll
                for (int i = 0; i < 16; ++i) { const int d0 = base + (i & 3) + 8 * (i >> 2); if (d0 < lo_d || d0 > hi_d) S[i] = -1e30f; }
            }

#pragma unroll
            for (int i = 0; i < 16; ++i) S[i] = __builtin_amdgcn_exp2f(S[i]);
            l += ((S[0] + S[1]) + (S[2] + S[3])) + ((S[4] + S[5]) + (S[6] + S[7])) + (((S[8] + S[9]) + (S[10] + S[11])) + ((S[12] + S[13]) + (S[14] + S[15])));
#pragma unroll
            for (int sp = 0; sp < 2; ++sp) {
                const f16x8 pf = pack_p(S, sp);
                O0 = __builtin_amdgcn_mfma_f32_32x32x16_f16(vf[sp][0], pf, O0, 0, 0, 0);
                O1 = __builtin_amdgcn_mfma_f32_32x32x16_f16(vf[sp][1], pf, O1, 0, 0, 0);
            }
        }
#undef ATT_KREAD
        const float inv = 1.0f / (l + __shfl_xor(l, 32));
#pragma unroll
        for (int dt = 0; dt < 2; ++dt)
#pragma unroll
            for (int kk = 0; kk < 2; ++kk) {
                u32x2 glo = {gw[dt][kk][0], gw[dt][kk][1]}, ghi = {gw[dt][kk][2], gw[dt][kk][3]};
#pragma unroll
                for (int w2 = 0; w2 < 2; ++w2) { const auto sw = __builtin_amdgcn_permlane32_swap(glo[w2], ghi[w2], false, false); glo[w2] = sw[0]; ghi[w2] = sw[1]; }
                const f16x4 g0 = __builtin_bit_cast(f16x4, glo), g1 = __builtin_bit_cast(f16x4, ghi);
                f16x4 o0, o1;
#pragma unroll
                for (int j = 0; j < 4; ++j) {
                    o0[j] = (f16)((dt ? O1[8 * kk + j] : O0[8 * kk + j]) * inv * (float)g0[j]);
                    o1[j] = (f16)((dt ? O1[8 * kk + 4 + j] : O0[8 * kk + 4 + j]) * inv * (float)g1[j]);
                }
                u32x2 a0 = __builtin_bit_cast(u32x2, o0), a1 = __builtin_bit_cast(u32x2, o1);
#pragma unroll
                for (int w2 = 0; w2 < 2; ++w2) { const auto sw = __builtin_amdgcn_permlane32_swap(a0[w2], a1[w2], false, false); a0[w2] = sw[0]; a1[w2] = sw[1]; }
                const u32x4 st = {a0[0], a0[1], a1[0], a1[1]};
                *(u32x4*)(MIX + grow * 1024 + head * 64 + 32 * dt + 8 * (2 * kk + h)) = st;
            }
    }
#undef ATT_LOAD
}

__device__ void fft_tables(LAS unsigned char* lds) {
    LAS f16* CF = (LAS f16*)(lds + LDS_TAB); LAS f16* SF = CF + 4096; LAS f16* NSF = SF + 4096;
    for (int e = threadIdx.x; e < 4096; e += NTHREADS) {
        const int jj = e & 7, lane = (e >> 3) & 63, kt = (e >> 9) & 1, s = e >> 10, h = lane >> 5;
        const int n = 16 * s + 8 * (jj >> 2) + 4 * h + (jj & 3), k = 32 * kt + (lane & 31);
        float sn, cs; sincospif((float)((n * k) & 63) * (1.0f / 32.0f), &sn, &cs);
        CF[e] = (f16)(cs * 0.125f); SF[e] = (f16)(sn * 0.125f); NSF[e] = (f16)(-sn * 0.125f);
    }
}
__device__ void p0_twiddle(const Args& a) {
    f32x2* TW = (f32x2*)(a.ws + WS_TW);
    for (int idx = blockIdx.x * NTHREADS + threadIdx.x; idx < 4096; idx += gridDim.x * NTHREADS) {
        const int lane = idx & 63, reg = (idx >> 6) & 15, kt = (idx >> 10) & 1, mt = idx >> 11, h = lane >> 5;
        const int n2 = 32 * mt + (reg & 3) + 8 * (reg >> 2) + 4 * h, k1 = 32 * kt + (lane & 31);
        float sn, cs; sincospif((float)(n2 * k1) * (1.0f / 2048.0f), &sn, &cs);
        TW[((((mt * 2 + kt) * 8 + (reg >> 1)) * 64 + lane) << 1) + (reg & 1)] = (f32x2){cs, sn};
    }
}
__device__ void fft_phase(const Args& a, LAS unsigned char* lds) {
    int tid_ = threadIdx.x; asm volatile("" : "+v"(tid_)); const int tid = tid_;
    const int lane = tid & 63, wid = __builtin_amdgcn_readfirstlane(tid >> 6), r = lane & 31, h = lane >> 5;
    const f16* Z = (const f16*)(a.ws + WS_Z); const f16* GF = (const f16*)(a.ws + WS_GF);
    const f32x2* TW = (const f32x2*)(a.ws + WS_TW);
    f16* FOUR = (f16*)(a.ws + WS_FOUR);
    const int G = gridDim.x;
    int unit = blockIdx.x;
    if (unit >= 768) return;
    f16x8 pin[4][4];
#define FFT_LOAD(un) do { const size_t _b0 = (size_t)(((un) >> 6) * 4 + (((un) >> 4) & 3)) * 16 + ((un) & 15); \
        int _tl = tid; asm volatile("" : "+v"(_tl)); \
        _Pragma("unroll") for (int it = 0; it < 4; ++it) { const f16* zp = Z + (_b0 * 4096 + 2 * (_tl + NTHREADS * it)) * 16; \
            _Pragma("unroll") for (int q = 0; q < 4; ++q) pin[it][q] = *(const f16x8*)(zp + 8 * q); } } while (0)
    FFT_LOAD(unit);
#pragma unroll 1
    for (; unit < 768; unit += G) {
    const int cg8 = unit & 15, g = (unit >> 4) & 3, b = unit >> 6;
    const size_t blk0 = (size_t)((b * 4 + g) * 16 + cg8) * 4096;
    __syncthreads();
#pragma unroll
    for (int it = 0; it < 4; ++it) {
        const int token = 2 * (tid + NTHREADS * it);
        const int n1 = token >> 6, n2 = token & 63;
        const int off = n1 * 128 + (((n2 >> 4) ^ (n1 & 3)) << 5) + (n2 & 15) * 2;
#pragma unroll
        for (int ch = 0; ch < 8; ++ch) {
            *(LAS f16x2*)(lds + ch * 16384 + off) = (f16x2){pin[it][0][ch], pin[it][2][ch]};
            *(LAS f16x2*)(lds + ch * 16384 + 8192 + off) = (f16x2){pin[it][1][ch], pin[it][3][ch]};
        }
    }
    __syncthreads();
    LAS unsigned char* img = lds + wid * 16384;
    const LAS f16x8* CF = (const LAS f16x8*)(lds + LDS_TAB) + lane; const LAS f16x8* SF = CF + 512; const LAS f16x8* NSF = SF + 512;
    const int blk = (lane >> 4) & 1, tq = (lane & 15) >> 2, tp = lane & 3;
    f32x16 X[2][2];
#pragma unroll
    for (int i = 0; i < 2; ++i)
#pragma unroll
        for (int j = 0; j < 2; ++j)
#pragma unroll
            for (int e = 0; e < 16; ++e) X[i][j][e] = 0.f;
#pragma unroll
    for (int mt = 0; mt < 2; ++mt) {
        f32x16 Yr[2], Yi[2];
#pragma unroll
        for (int j = 0; j < 2; ++j)
#pragma unroll
            for (int e = 0; e < 16; ++e) { Yr[j][e] = 0.f; Yi[j][e] = 0.f; }
#pragma unroll
        for (int which = 0; which < 2; ++which)
#pragma unroll
            for (int s = 0; s < 4; ++s) {
                LAS unsigned char* pa = img + which * 8192 + (16 * s + 4 * h + tq) * 128 + (((2 * mt + blk) ^ tq) << 5) + tp * 8;
                const f16x8 af = tr_pair(pa, pa + 8 * 128);
#pragma unroll
                for (int kt = 0; kt < 2; ++kt) {
                    const f16x8 cf = CF[(s * 2 + kt) * 64], sf = which ? NSF[(s * 2 + kt) * 64] : SF[(s * 2 + kt) * 64];
                    if (which == 0) { Yr[kt] = __builtin_amdgcn_mfma_f32_32x32x16_f16(af, cf, Yr[kt], 0, 0, 0); Yi[kt] = __builtin_amdgcn_mfma_f32_32x32x16_f16(af, sf, Yi[kt], 0, 0, 0); }
                    else { Yr[kt] = __builtin_amdgcn_mfma_f32_32x32x16_f16(af, sf, Yr[kt], 0, 0, 0); Yi[kt] = __builtin_amdgcn_mfma_f32_32x32x16_f16(af, cf, Yi[kt], 0, 0, 0); }
                }
            }
        f16x8 trf[2][2], tif[2][2];
#pragma unroll
        for (int kt = 0; kt < 2; ++kt) {
            int lane_l = lane; asm volatile("" : "+v"(lane_l));
            const f32x4* tw = (const f32x4*)TW + ((mt * 2 + kt) * 8) * 64 + lane_l;
            f32x16 tr, ti;
#pragma unroll
            for (int p = 0; p < 8; ++p) { const f32x4 cs = tw[p * 64];
                tr[2 * p] = Yr[kt][2 * p] * cs[0] - Yi[kt][2 * p] * cs[1]; ti[2 * p] = Yr[kt][2 * p] * cs[1] + Yi[kt][2 * p] * cs[0];
                tr[2 * p + 1] = Yr[kt][2 * p + 1] * cs[2] - Yi[kt][2 * p + 1] * cs[3]; ti[2 * p + 1] = Yr[kt][2 * p + 1] * cs[3] + Yi[kt][2 * p + 1] * cs[2]; }
#pragma unroll
            for (int sp = 0; sp < 2; ++sp) { trf[kt][sp] = pack_p(tr, sp); tif[kt][sp] = pack_p(ti, sp); }
        }
#pragma unroll
        for (int sp = 0; sp < 2; ++sp)
#pragma unroll
            for (int mt2 = 0; mt2 < 2; ++mt2) {
                const f16x8 cf = CF[((2 * mt + sp) * 2 + mt2) * 64], nsf = NSF[((2 * mt + sp) * 2 + mt2) * 64];
#pragma unroll
                for (int kt = 0; kt < 2; ++kt) {
                    X[mt2][kt] = __builtin_amdgcn_mfma_f32_32x32x16_f16(cf, trf[kt][sp], X[mt2][kt], 0, 0, 0);
                    X[mt2][kt] = __builtin_amdgcn_mfma_f32_32x32x16_f16(nsf, tif[kt][sp], X[mt2][kt], 0, 0, 0);
                }
            }
    }
#pragma unroll
    for (int mt2 = 0; mt2 < 2; ++mt2)
#pragma unroll
        for (int kt = 0; kt < 2; ++kt)
#pragma unroll
            for (int e = 0; e < 16; ++e) {
                const int token = 32 * kt + r + 64 * (32 * mt2 + (e & 3) + 8 * (e >> 2) + 4 * h);
                *(LAS f16*)(img + token * 2) = (f16)X[mt2][kt][e];
            }
    f16x8 gt[4][2];
    int tl = tid; asm volatile("" : "+v"(tl));
#pragma unroll
    for (int it = 0; it < 4; ++it) { const f16* gp = GF + (blk0 + 2 * (tl + NTHREADS * it)) * 8; gt[it][0] = *(const f16x8*)gp; gt[it][1] = *(const f16x8*)(gp + 8); }
    { const int un = (unit + G < 768) ? unit + G : unit; FFT_LOAD(un); }
    __syncthreads();
#pragma unroll
    for (int it = 0; it < 4; ++it) {
        const int token = 2 * (tl + NTHREADS * it);
        f16x8 o0, o1;
#pragma unroll
        for (int ch = 0; ch < 8; ++ch) {
            const f16x2 v = *(const LAS f16x2*)(lds + ch * 16384 + token * 2);
            o0[ch] = (f16)((float)v[0] * (float)gt[it][0][ch]); o1[ch] = (f16)((float)v[1] * (float)gt[it][1][ch]);
        }
        *(f16x8*)(FOUR + (blk0 + token) * 8) = o0; *(f16x8*)(FOUR + (blk0 + token) * 8 + 8) = o1;
    }
    }
#undef FFT_LOAD
}

#define XB_TMO      128
#define XB_XCNT(j)  (256  + 64 * (j))
#define XB_XSUB(j)  (1280 + 64 * (j))
#define XB_XGEN(j)  (2304 + 64 * (j))
#define XB_TOP      3328
#define XB_TOPGEN   3392
#define XCD_BAR_WORDS 3456
#define XB_SPIN_CAP (1u << 18)
__device__ __forceinline__ unsigned xb_ld(unsigned* p)              { return __hip_atomic_load(p, __ATOMIC_RELAXED, __HIP_MEMORY_SCOPE_AGENT); }
__device__ __forceinline__ unsigned xb_add(unsigned* p, unsigned v) { return __hip_atomic_fetch_add(p, v, __ATOMIC_RELAXED, __HIP_MEMORY_SCOPE_AGENT); }
__device__ __forceinline__ unsigned xb_xcc_id() { return (unsigned)__builtin_amdgcn_s_getreg((3 << 11) | 20) & 0xFu; }
#define XB_SPIN(cond, bar) do { unsigned _sp = 0; while (cond) { __builtin_amdgcn_s_sleep(1); \
    if ((++_sp & 255u) == 0u) { if (xb_ld(&(bar)[XB_TMO])) break; if (_sp > XB_SPIN_CAP) { atomicAdd(&(bar)[XB_TMO], 1u); break; } } } } while (0)
struct XcdBarrier { unsigned* bar; unsigned x; volatile LAS unsigned* st; };
__device__ __forceinline__ XcdBarrier xcd_barrier_post(unsigned* bar, volatile LAS unsigned* st) {
    XcdBarrier b; b.bar = bar; b.x = xb_xcc_id(); b.st = st;
    if (threadIdx.x == 0) (void)xb_add(&bar[XB_XCNT(b.x)], 1u);
    return b;
}
__device__ __forceinline__ void xcd_barrier_complete(unsigned* bar, unsigned x, unsigned& nloc, unsigned& nx) {
    const unsigned G = gridDim.x * gridDim.y * gridDim.z;
    unsigned sum, cnt, mine, sp = 0u;
    for (;;) {
        sum = 0u; cnt = 0u; mine = 0u;
#pragma unroll 1
        for (unsigned j = 0; j < 16; ++j) { const unsigned c = xb_ld(&bar[XB_XCNT(j)]); sum += c; cnt += (c > 0u) ? 1u : 0u; mine = (j == x) ? c : mine; }
        if (sum == G) break;
        __builtin_amdgcn_s_sleep(1);
        if ((++sp & 255u) == 0u) { if (xb_ld(&bar[XB_TMO])) break; if (sp > XB_SPIN_CAP) { atomicAdd(&bar[XB_TMO], 1u); break; } }
    }
    nloc = mine > 0u ? mine : 1u; nx = cnt > 0u ? cnt : 1u;
}
__device__ __forceinline__ void xcd_barrier(const XcdBarrier& b) {
    asm volatile("s_waitcnt vmcnt(0)" ::: "memory");
    __syncthreads();
    if (threadIdx.x == 0) {
        unsigned* bar = b.bar; asm volatile("" : "+s"(bar));
        __builtin_amdgcn_s_waitcnt(0);
        unsigned nloc = b.st[0], nx = b.st[1];
        if (nloc == 0u) { xcd_barrier_complete(bar, b.x, nloc, nx); b.st[0] = nloc; b.st[1] = nx; }
        const unsigned old = xb_add(&bar[XB_XSUB(b.x)], 1u);
        const unsigned gen = old / nloc;
        if (old + 1u == (gen + 1u) * nloc) {
            __builtin_amdgcn_fence(__ATOMIC_RELEASE, "agent");
            asm volatile("s_waitcnt vmcnt(0)" ::: "memory");
            const unsigned og = xb_add(&bar[XB_TOP], 1u);
            const unsigned tg = og / nx;
            if (og + 1u == (tg + 1u) * nx) xb_add(&bar[XB_TOPGEN], 1u);
            else XB_SPIN(xb_ld(&bar[XB_TOPGEN]) == tg, bar);
            __builtin_amdgcn_fence(__ATOMIC_ACQUIRE, "agent");
            xb_add(&bar[XB_XGEN(b.x)], 1u);
            asm volatile("s_waitcnt vmcnt(0)" ::: "memory");
        } else {
            XB_SPIN(xb_ld(&bar[XB_XGEN(b.x)]) == gen, bar);
            __builtin_amdgcn_fence(__ATOMIC_ACQUIRE, "agent");
            asm volatile("s_waitcnt vmcnt(0)" ::: "memory");
        }
    }
    __syncthreads();
}

__global__ void __launch_bounds__(NTHREADS, 2) hymba_fwd(Args a) {
    extern __shared__ __attribute__((aligned(16))) unsigned char lds_raw[];
    LAS unsigned char* lds = (LAS unsigned char*)lds_raw;
    if (threadIdx.x < 2) ((volatile LAS unsigned*)(lds + LDS_MISC))[threadIdx.x] = 0u;
    __syncthreads();
    const XcdBarrier bar = xcd_barrier_post((unsigned*)(a.ws + WS_BAR), (volatile LAS unsigned*)(lds + LDS_MISC));
    const int lo = a.ph_lo, hi = a.ph_hi;
#define IN(k) (lo <= (k) && (k) < hi)
#define SEAM(k) do { if (IN(k) && IN((k) + 1)) xcd_barrier(bar); } while (0)
    if (IN(0)) { p0_mmat(a, lds); p0_rope(a); p0_twiddle(a); p_weights_plain(a); }
    SEAM(0);
    if (IN(1)) { p_weights_prod(a, lds); p0_xconv(a); }
    fft_tables(lds);
    SEAM(1);
#pragma unroll 1
    for (int layer = 0; layer < 2; ++layer) {
        const int pb = 2 + 3 * layer;
        if (IN(pb)) {
            pg8::Gemm g{(const f16*)(a.ws + WS_XH), (const f16*)(a.ws + WS_W1T) + (size_t)layer * N1 * 1024, MROWS, N1, 1024, nullptr};
            pg8::StaticOrder S; S.init(MROWS, N1, gridDim.x, blockIdx.x);
            const bool split = (gridDim.x == 256);
            if (split) S.hi = 2048;
            Epi1 E{a.ws, a.qgain + layer * 64, a.kgain + layer * 64};
            pg8::gemm_phase<Epi1, false>(lds, g, S, E);
            if (split) {
                unsigned* tailq = (unsigned*)(a.ws + WS_BAR) + 3584 + 64 * layer;
                volatile LAS unsigned* qslot = (volatile LAS unsigned*)(lds + LDS_MISC) + 8;
                for (;;) {
                    if (threadIdx.x == 0) *qslot = __hip_atomic_fetch_add(tailq, 1u, __ATOMIC_RELAXED, __HIP_MEMORY_SCOPE_AGENT);
                    __syncthreads();
                    const unsigned q = *qslot;
                    __syncthreads();
                    if (q >= 256u) break;
                    pg8::Unit tu; S.unit_of(2048 + (int)(q >> 2), tu);
                    gemm1_tail_quadrant(lds, g.A, g.Bt, a.ws, tu.pm, tu.pn, (int)((q >> 1) & 1u), (int)(q & 1u));
                }
            }
        }
        SEAM(pb);
        if (IN(pb + 1)) {
#pragma unroll 1
            for (int part = 0; part < 2; ++part) {
                if ((part ^ (int)((blockIdx.x >> 3) & 1)) == 0) attn_phase(a, lds, layer);
                else fft_phase(a, lds);
            }
        }
        SEAM(pb + 1);
        if (IN(pb + 2)) {
            pg8::Gemm g{(const f16*)(a.ws + WS_MIX), (const f16*)(a.ws + WS_W2T) + (size_t)layer * 1024 * 1024, MROWS, 1024, 1024, (const f16*)(a.ws + WS_FOUR)};
            pg8::StaticOrder S; S.init(MROWS, 1024, gridDim.x, blockIdx.x);
            Epi2 E{a.x_prompt, a.x_sample, a.out, (f16*)(a.ws + WS_XH), (float*)(a.ws + WS_SS), layer};
            pg8::gemm_phase<Epi2, true>(lds, g, S, E);
        }
        if (layer == 0) SEAM(pb + 2);
    }
#undef IN
#undef SEAM
}

extern "C" void kernel_launch(void* const* d_in, const int* in_sizes, int n_in, void* d_out, int out_size, void* d_ws, size_t ws_size, hipStream_t stream) {
    static int grid = 0;
    if (grid == 0) {
        int dev = 0, cus = 0, per_cu = 0;
        hipGetDevice(&dev);
        hipDeviceGetAttribute(&cus, hipDeviceAttributeMultiprocessorCount, dev);
        hipFuncSetAttribute((const void*)hymba_fwd, hipFuncAttributeMaxDynamicSharedMemorySize, LDS_BYTES);
        hipOccupancyMaxActiveBlocksPerMultiprocessor(&per_cu, (const void*)hymba_fwd, NTHREADS, LDS_BYTES);
        if (per_cu < 1) { fprintf(stderr, "kernel_launch: occupancy query says %d blocks/CU\n", per_cu); per_cu = 1; }
        if (per_cu > 1) per_cu = 1;
        grid = cus * per_cu;
        if (ws_size < WS_END) { fprintf(stderr, "kernel_launch: workspace too small (%zu < %zu)\n", ws_size, (size_t)WS_END); grid = -1; }
    }
    if (grid < 0) return;
    hipMemsetAsync((char*)d_ws + WS_BAR, 0, 16384, stream);
    Args a{};
    a.x_prompt = (const float*)d_in[0]; a.x_sample = (const float*)d_in[1]; a.norm_gain = (const float*)d_in[2]; a.w_in = (const float*)d_in[3];
    a.qgain = (const float*)d_in[4]; a.kgain = (const float*)d_in[5]; a.sink = (const float*)d_in[6]; a.w_four = (const float*)d_in[7]; a.w_out = (const float*)d_in[8];
    a.out = (float*)d_out; a.ws = (unsigned char*)d_ws; a.ph_lo = 0; a.ph_hi = 8;
    void* args[] = {&a};
    hipError_t e = hipLaunchCooperativeKernel((const void*)hymba_fwd, dim3(grid), dim3(NTHREADS), args, LDS_BYTES, stream);
    if (e != hipSuccess) fprintf(stderr, "kernel_launch: cooperative launch failed: %s (grid %d)\n", hipGetErrorString(e), grid);
}
```

```cpp
#include <hip/hip_runtime.h>
#include <cstdio>
#include <cstdint>

#define LAS __attribute__((address_space(3)))
typedef _Float16 f16;
typedef _Float16 f16x8 __attribute__((ext_vector_type(8)));
typedef _Float16 f16x4 __attribute__((ext_vector_type(4)));
typedef _Float16 f16x2 __attribute__((ext_vector_type(2)));
typedef float f32x4 __attribute__((ext_vector_type(4)));
typedef float f32x2 __attribute__((ext_vector_type(2)));
typedef unsigned u32x4 __attribute__((ext_vector_type(4)));
typedef unsigned u32x2 __attribute__((ext_vector_type(2)));

constexpr int SEQ = 4096, NBATCH = 12, MROWS = NBATCH * SEQ  , DM = 1024, INW = 2304, N1 = 2816;
constexpr int ROWS_PROMPT = 4 * SEQ;
constexpr float EPS = 1e-6f;
constexpr float LOG2E = 1.4426950408889634f;
constexpr int NTHREADS = 512;
constexpr int LDS_RS = 152 * 1024 + 256;
constexpr int LDS_BYTES = LDS_RS + 9 * 256 * 2;
constexpr int LDS_MISC = 152 * 1024;
constexpr int LDS_TAB = 128 * 1024;

constexpr size_t SZ_XH = (size_t)MROWS * 1024 * 2, SZ_Q = (size_t)MROWS * 512 * 2, SZ_KV = (size_t)MROWS * 128 * 2;
constexpr size_t WS_XH = 0;
constexpr size_t WS_Q = WS_XH + SZ_XH;
constexpr size_t WS_K = WS_Q + SZ_Q;
constexpr size_t WS_V = WS_K + SZ_KV;
constexpr size_t WS_GA = WS_V + SZ_KV;
constexpr size_t WS_GF = WS_GA + SZ_Q;
constexpr size_t WS_Z = WS_GF + SZ_Q;
constexpr size_t WS_MIX = WS_Z + SZ_XH;
constexpr size_t WS_FOUR = WS_MIX + SZ_XH;
constexpr size_t WS_SS = WS_FOUR + SZ_Q;
constexpr size_t WS_W1T = WS_SS + (size_t)MROWS * 16 * 4;
constexpr size_t WS_W2T = WS_W1T + (size_t)2 * N1 * 1024 * 2;
constexpr size_t WS_MM = WS_W2T + (size_t)2 * 1024 * 1024 * 2;
constexpr size_t WS_ROPE = WS_MM + (size_t)2 * 4 * 128 * 256 * 4;
constexpr size_t WS_TW = WS_ROPE + (size_t)2 * 4096 * 32 * 4;
constexpr size_t WS_ROT = WS_TW + (size_t)4096 * 8;
constexpr size_t WS_BAR = WS_ROT + 1024;
constexpr size_t WS_END = WS_BAR + 16384;

struct Args {
    const float* x_prompt; const float* x_sample; const float* norm_gain; const float* w_in; const float* qgain; const float* kgain;
    const float* sink; const float* w_four; const float* w_out; float* out; unsigned char* ws; int ph_lo, ph_hi;
};

namespace pg8 {
constexpr int BM = 256, BK = 64, HALF = 128, HTB = HALF * BK * 2, STAGE_BYTES = 8 * HTB, NXCD = 8, WGM = 4;
__device__ __forceinline__ int lds_byte(int r, int c) { const int st = (r >> 4) * 2 + (c >> 5), rr = r & 15, cc = c & 31, ob = rr * 64 + cc * 2; return st * 1024 + (ob ^ (((ob >> 9) & 1) << 5)); }
__device__ __forceinline__ void stage_rc(int b, int& R, int& C) { const int st = b / 1024, sb = b % 1024, swz = sb ^ (((sb >> 9) & 1) << 5); R = (st >> 1) * 16 + swz / 64; C = (st & 1) * 32 + (swz % 64) / 2; }
struct Unit { int pm, pn; };
struct Gemm { const f16* A; const f16* Bt; int M, N, K; const f16* A2; };
struct StaticOrder {
    int nM, nN, nwg, G, c, hi;
    __device__ void init(int M, int N, int G_, int c_) { nM = M / BM; nN = N / BM; nwg = nM * nN; G = G_; c = c_; hi = nwg; }
    __device__ bool next(int i, Unit& u) const { const long L = (long)i * G + c; if (L >= hi) return false; unit_of((int)L, u); return true; }
    __device__ void unit_of(int L, Unit& u) const {
        int wgid = L; { const int q = nwg / NXCD, r = nwg % NXCD, xcd = wgid % NXCD, off = wgid / NXCD; wgid = (xcd < r ? xcd * (q + 1) : r * (q + 1) + (xcd - r) * q) + off; }
        const int nig = WGM * nN, gid = wgid / nig, fm = gid * WGM, gsz = (nM - fm) < WGM ? (nM - fm) : WGM;
        u.pm = fm + ((wgid % nig) % gsz); u.pn = (wgid % nig) / gsz;
    }
};

template <class Epi, bool SPLITA>
__device__ __forceinline__ void gemm_phase(LAS unsigned char* lds, const Gemm g, const StaticOrder& S, const Epi& E) {
    int tid_ = threadIdx.x; asm volatile("" : "+v"(tid_));
    const int tid = tid_, wid = __builtin_amdgcn_readfirstlane(tid >> 6), lane = tid & 63, wr = wid >> 2, wc = wid & 3, fr = lane & 15, fq = lane >> 4;
    const int K = g.K, nt = K / BK;
    unsigned voffA[2], voffF[2];
#pragma unroll
    for (int i = 0; i < 2; ++i) { int R, C; stage_rc(tid * 16 + i * 8192, R, C); voffA[i] = (unsigned)(R * K + C) * 2u; voffF[i] = (unsigned)((C >> 3) * 65536 + R * 16); }
    const size_t kstep = (size_t)(BK * 2);
    const size_t hstep = (size_t)HALF * K * 2;
    const size_t tstep = 2 * hstep;
    const unsigned ldsw = (unsigned)wid * 1024u;
    const int aoff = lds_byte(wr * 64 + fr, fq * 8), boff = lds_byte(wc * 32 + fr, fq * 8);
#define PG8_SA(b, h) (((b) * 2 + (h)) * HTB)
#define PG8_SB(b, h) ((4 + (b) * 2 + (h)) * HTB)
#define PG8_STAGE(bufoff, gbase) do { _Pragma("unroll") for (int _i = 0; _i < 2; ++_i) \
        __builtin_amdgcn_global_load_lds((const unsigned*)((const char*)(gbase) + voffA[_i]), (LAS unsigned*)(lds + (bufoff) + ldsw + _i * 8192), 16, 0, 0); } while (0)
#define PG8_STAGE_A(bufoff, pm_, kt_, half_) do { const char* _b; unsigned _v0, _v1; \
        if (SPLITA && (kt_) >= 8) { const int _k2 = (kt_) - 8; _b = (const char*)g.A2 + ((size_t)(((((pm_) >> 4) * 4 + (_k2 >> 1)) * 16 + (_k2 & 1) * 8)) * 4096 + ((pm_) & 15) * 256 + (half_) * 128) * 16; _v0 = voffF[0]; _v1 = voffF[1]; } \
        else { _b = (const char*)g.A + (size_t)(pm_) * tstep + (size_t)(half_) * hstep + (size_t)(kt_) * kstep; _v0 = voffA[0]; _v1 = voffA[1]; } \
        __builtin_amdgcn_global_load_lds((const unsigned*)(_b + _v0), (LAS unsigned*)(lds + (bufoff) + ldsw), 16, 0, 0); \
        __builtin_amdgcn_global_load_lds((const unsigned*)(_b + _v1), (LAS unsigned*)(lds + (bufoff) + ldsw + 8192), 16, 0, 0); } while (0)
#define PG8_LDA(dst, b, h) do { _Pragma("unroll") for (int m = 0; m < 4; ++m) _Pragma("unroll") for (int k = 0; k < 2; ++k) dst[m][k] = *(const LAS f16x8*)(lds + PG8_SA(b, h) + aoff + m * 2048 + k * 1024); } while (0)
#define PG8_LDB(dst, b, h) do { _Pragma("unroll") for (int n = 0; n < 2; ++n) _Pragma("unroll") for (int k = 0; k < 2; ++k) dst[n][k] = *(const LAS f16x8*)(lds + PG8_SB(b, h) + boff + n * 2048 + k * 1024); } while (0)
#define PG8_MMA(ai, bj, At, Bt) do { __builtin_amdgcn_s_setprio(1); _Pragma("unroll") for (int m = 0; m < 4; ++m) _Pragma("unroll") for (int n = 0; n < 2; ++n) _Pragma("unroll") for (int k = 0; k < 2; ++k) \
        acc[ai][bj][m][n] = __builtin_amdgcn_mfma_f32_16x16x32_f16(Bt[n][k], At[m][k], acc[ai][bj][m][n], 0, 0, 0); __builtin_amdgcn_s_setprio(0); } while (0)
#define PG8_WAIT_V(n) asm volatile("s_waitcnt vmcnt(" #n ")" ::: "memory")
#define PG8_WAIT_L(n) asm volatile("s_waitcnt lgkmcnt(" #n ")" ::: "memory")
#define PG8_BAR __builtin_amdgcn_s_barrier()
#define PG8_SCHED __builtin_amdgcn_sched_barrier(0)
    Unit cur, nxt; int ui = 0;
    if (!S.next(0, cur)) return;
    E.prepare(lds, S, tid);
    f32x4 acc[2][2][4][2];
#pragma unroll
    for (int a = 0; a < 2; ++a)
#pragma unroll
        for (int b = 0; b < 2; ++b)
#pragma unroll
            for (int m = 0; m < 4; ++m)
#pragma unroll
                for (int n = 0; n < 2; ++n) acc[a][b][m][n] = (f32x4){0.f, 0.f, 0.f, 0.f};
    f16x8 At[4][2], B0[2][2], B1[2][2];
    const char* cB = (const char*)g.Bt + (size_t)cur.pn * tstep;
    PG8_STAGE(PG8_SB(0, 0), cB); PG8_STAGE(PG8_SB(0, 1), cB + hstep); PG8_STAGE_A(PG8_SA(0, 0), cur.pm, 0, 0); PG8_STAGE_A(PG8_SA(0, 1), cur.pm, 0, 1);
    if (wr == 1) PG8_BAR;
    PG8_WAIT_V(2); PG8_BAR;
    PG8_STAGE(PG8_SB(1, 0), cB + kstep); PG8_STAGE_A(PG8_SA(1, 0), cur.pm, 1, 0); PG8_STAGE(PG8_SB(1, 1), cB + hstep + kstep);
    PG8_WAIT_V(6); PG8_BAR;
    for (;;) {
        const bool has_next = S.next(ui + 1, nxt);
        const int npm = has_next ? nxt.pm : cur.pm; const char* nB = has_next ? (const char*)g.Bt + (size_t)nxt.pn * tstep : cB;
        for (int t = 0; t < nt; t += 2) {
            const bool last = (t == nt - 2);
            const int pm2 = last ? npm : cur.pm, kt2 = last ? 0 : t + 2;
            const char* b2 = last ? nB : cB + (size_t)(t + 2) * kstep; const char* b3 = b2 + kstep;
            PG8_LDB(B0, 0, 0); PG8_LDB(B1, 0, 1); PG8_SCHED; PG8_LDA(At, 0, 0); PG8_STAGE_A(PG8_SA(1, 1), cur.pm, t + 1, 1);
            PG8_WAIT_V(8); PG8_WAIT_L(0); PG8_BAR; PG8_MMA(0, 0, At, B0); PG8_MMA(0, 1, At, B1); PG8_BAR; PG8_SCHED;
            PG8_LDA(At, 0, 1); PG8_STAGE(PG8_SB(0, 0), b2); PG8_STAGE(PG8_SB(0, 1), b2 + hstep); PG8_STAGE_A(PG8_SA(0, 0), pm2, kt2, 0);
            PG8_WAIT_V(8); PG8_WAIT_L(0); PG8_BAR; PG8_MMA(1, 0, At, B0); PG8_MMA(1, 1, At, B1); PG8_BAR; PG8_SCHED;
            PG8_LDB(B0, 1, 0); PG8_LDB(B1, 1, 1); PG8_SCHED; PG8_LDA(At, 1, 0); PG8_STAGE_A(PG8_SA(0, 1), pm2, kt2, 1);
            PG8_WAIT_V(8); PG8_WAIT_L(0); PG8_BAR; PG8_MMA(0, 0, At, B0); PG8_MMA(0, 1, At, B1); PG8_BAR; PG8_SCHED;
            PG8_LDA(At, 1, 1); PG8_STAGE(PG8_SB(1, 0), b3); PG8_STAGE(PG8_SB(1, 1), b3 + hstep); PG8_STAGE_A(PG8_SA(1, 0), pm2, kt2 + 1, 0);
            PG8_WAIT_V(8); PG8_WAIT_L(0); PG8_BAR; PG8_MMA(1, 0, At, B0); PG8_MMA(1, 1, At, B1); PG8_BAR; PG8_SCHED;
        }
        if (wr == 0) PG8_BAR;
        E(acc, cur, ui, lds, wr, wc, fr, fq);
        if (!has_next) break;
#pragma unroll
        for (int a = 0; a < 2; ++a)
#pragma unroll
            for (int b = 0; b < 2; ++b)
#pragma unroll
                for (int m = 0; m < 4; ++m)
#pragma unroll
                    for (int n = 0; n < 2; ++n) acc[a][b][m][n] = (f32x4){0.f, 0.f, 0.f, 0.f};
        cur = nxt; cB = nB; ++ui;
        if (wr == 1) PG8_BAR;
    }
    PG8_WAIT_V(0);
    PG8_BAR;
#undef PG8_SA
#undef PG8_SB
#undef PG8_STAGE
#undef PG8_STAGE_A
#undef PG8_LDA
#undef PG8_LDB
#undef PG8_MMA
#undef PG8_WAIT_V
#undef PG8_WAIT_L
#undef PG8_BAR
#undef PG8_SCHED
}
}

__host__ __device__ __forceinline__ int colmap(int rho) { const int bj = rho >> 7, wc = (rho >> 5) & 3, n = (rho >> 4) & 1, fq = (rho >> 2) & 3, j = rho & 3; return 64 * wc + 32 * bj + 8 * fq + 4 * n + j; }

__device__ __forceinline__ float silu_f(float z) { return z * __builtin_amdgcn_rcpf(1.0f + __builtin_amdgcn_exp2f(-LOG2E * z)); }
__device__ __forceinline__ u32x4 pack8(const float* v) {
    f16x8 h;
#pragma unroll
    for (int i = 0; i < 8; ++i) h[i] = (f16)v[i];
    return __builtin_bit_cast(u32x4, h);
}

__device__ __forceinline__ void gemm1_tail_quadrant(LAS unsigned char* lds, const f16* A, const f16* Bt, unsigned char* ws, int pm, int pn, int ai, int bj) {
    using namespace pg8;
    int tid_ = threadIdx.x; asm volatile("" : "+v"(tid_));
    const int tid = tid_, wid = __builtin_amdgcn_readfirstlane(tid >> 6), lane = tid & 63, wr = wid >> 2, wc = wid & 3, fr = lane & 15, fq = lane >> 4;
    constexpr int K = 1024, NT = K / BK;
    unsigned voff[2];
#pragma unroll
    for (int i = 0; i < 2; ++i) { int R, C; stage_rc(tid * 16 + i * 8192, R, C); voff[i] = (unsigned)(R * K + C) * 2u; }
    const char* abase = (const char*)A + ((size_t)pm * 256 + ai * 128) * K * 2;
    const char* bbase = (const char*)Bt + ((size_t)pn * 256 + bj * 128) * K * 2;
    const unsigned ldsw = (unsigned)wid * 1024u;
    const int aoff = lds_byte(wr * 64 + fr, fq * 8), boff = lds_byte(wc * 32 + fr, fq * 8);
#define QSTAGE(s_, kt_) do { _Pragma("unroll") for (int _i = 0; _i < 2; ++_i) { \
        __builtin_amdgcn_global_load_lds((const unsigned*)(abase + (size_t)(kt_) * (BK * 2) + voff[_i]), (LAS unsigned*)(lds + (s_) * 32768 + ldsw + _i * 8192), 16, 0, 0); \
        __builtin_amdgcn_global_load_lds((const unsigned*)(bbase + (size_t)(kt_) * (BK * 2) + voff[_i]), (LAS unsigned*)(lds + (s_) * 32768 + 16384 + ldsw + _i * 8192), 16, 0, 0); } } while (0)
    f32x4 acc[4][2];
#pragma unroll
    for (int m = 0; m < 4; ++m)
#pragma unroll
        for (int n = 0; n < 2; ++n) acc[m][n] = (f32x4){0.f, 0.f, 0.f, 0.f};
    QSTAGE(0, 0); QSTAGE(1, 1); QSTAGE(2, 2);
#pragma unroll 1
    for (int t = 0; t < NT; ++t) {
        if (t <= NT - 3) asm volatile("s_waitcnt vmcnt(8)" ::: "memory"); else if (t == NT - 2) asm volatile("s_waitcnt vmcnt(4)" ::: "memory"); else asm volatile("s_waitcnt vmcnt(0)" ::: "memory");
        __builtin_amdgcn_s_barrier();
        if (t + 3 < NT) QSTAGE((t + 3) & 3, t + 3);
        LAS unsigned char* sl = lds + (t & 3) * 32768;
        f16x8 At[4][2], Bf[2][2];
#pragma unroll
        for (int m = 0; m < 4; ++m)
#pragma unroll
            for (int k = 0; k < 2; ++k) At[m][k] = *(const LAS f16x8*)(sl + aoff + m * 2048 + k * 1024);
#pragma unroll
        for (int n = 0; n < 2; ++n)
#pragma unroll
            for (int k = 0; k < 2; ++k) Bf[n][k] = *(const LAS f16x8*)(sl + 16384 + boff + n * 2048 + k * 1024);
#pragma unroll
        for (int m = 0; m < 4; ++m)
#pragma unroll
            for (int n = 0; n < 2; ++n)
#pragma unroll
                for (int k = 0; k < 2; ++k) acc[m][n] = __builtin_amdgcn_mfma_f32_16x16x32_f16(Bf[n][k], At[m][k], acc[m][n], 0, 0, 0);
    }
#undef QSTAGE
    const float* SS = (const float*)(ws + WS_SS); f16* Z = (f16*)(ws + WS_Z);
    const int row0 = pm * 256 + ai * 128 + wr * 64 + fr;
    f32x4 part[4];
#pragma unroll
    for (int m = 0; m < 4; ++m) part[m] = *(const f32x4*)(SS + (size_t)(row0 + m * 16) * 16 + 4 * fq);
#pragma unroll
    for (int m = 0; m < 4; ++m) {
        float t = (part[m][0] + part[m][1]) + (part[m][2] + part[m][3]);
        t += __shfl_xor(t, 16); t += __shfl_xor(t, 32);
        const float rs = __builtin_amdgcn_rsqf(t * (1.0f / 1024.0f) + EPS);
        const int row = row0 + m * 16;
        float v[8];
#pragma unroll
        for (int e = 0; e < 8; ++e) v[e] = acc[m][e >> 2][e & 3] * rs;
        const int cg8 = 8 * (wc & 1) + 4 * bj + fq;
        f16* p = Z + (((size_t)(((row >> 12) * 4 + (pn - 7)) * 16 + cg8) * 4096 + (row & 4095)) * 2 + (wc >> 1)) * 8;
        *(u32x4*)p = pack8(v);
    }
    asm volatile("s_waitcnt vmcnt(0)" ::: "memory");
    __syncthreads();
}

struct Epi1 {
    unsigned char* __restrict__ ws; const float* __restrict__ qg; const float* __restrict__ kg;
    __device__ __forceinline__ void prepare(LAS unsigned char* lds, const pg8::StaticOrder& S, int tid) const {
        const float* SS = (const float*)(ws + WS_SS);
        f32x4 p0[9], p1[9];
#pragma unroll
        for (int i = 0; i < 9; ++i) {
            pg8::Unit u; p0[i] = (f32x4){0.f, 0.f, 0.f, 0.f}; p1[i] = p0[i];
            if (S.next(i, u)) { const float* sp = SS + (size_t)(u.pm * 256 + (tid >> 1)) * 16 + (tid & 1) * 8; p0[i] = *(const f32x4*)sp; p1[i] = *(const f32x4*)(sp + 4); }
        }
#pragma unroll
        for (int i = 0; i < 9; ++i) {
            float t = ((p0[i][0] + p0[i][1]) + (p0[i][2] + p0[i][3])) + ((p1[i][0] + p1[i][1]) + (p1[i][2] + p1[i][3]));
            t += __shfl_xor(t, 1);
            if ((tid & 1) == 0) ((LAS f16*)(lds + LDS_RS))[i * 256 + (tid >> 1)] = (f16)(1.0f / sqrtf(t * (1.0f / 1024.0f) + EPS));
        }
        __syncthreads();
    }
    __device__ __forceinline__ void operator()(const f32x4 (&acc)[2][2][4][2], const pg8::Unit& u, int ui, LAS unsigned char* lds, int wr, int wc, int fr_, int fq_) const {
        int fr = fr_, fq = fq_; asm volatile("" : "+v"(fr), "+v"(fq));
        const float* ropeC = (const float*)(ws + WS_ROPE); const float* ropeS = ropeC + 4096 * 32; const float* rot = (const float*)(ws + WS_ROT);
        f16* Q = (f16*)(ws + WS_Q); f16* K = (f16*)(ws + WS_K); f16* V = (f16*)(ws + WS_V); f16* GA = (f16*)(ws + WS_GA); f16* GF = (f16*)(ws + WS_GF); f16* Z = (f16*)(ws + WS_Z);
        const int pn = u.pn;
        const bool is_qk = (pn <= 1) || (pn == 2 && wc < 2);
        const int row0 = u.pm * 256 + wr * 64 + fr;
        float rsv[8];
#pragma unroll
        for (int i = 0; i < 8; ++i) rsv[i] = (float)((const LAS f16*)(lds + LDS_RS))[ui * 256 + wr * 64 + fr + (i >> 2) * 128 + (i & 3) * 16];
        if (is_qk) {
            const float* gain = (pn <= 1) ? qg : kg;
            const float oscale = (pn <= 1) ? (0.125f * LOG2E) : 1.0f;
            f32x4 gv[2][2];
#pragma unroll
            for (int bj = 0; bj < 2; ++bj)
#pragma unroll
                for (int n = 0; n < 2; ++n) gv[bj][n] = *(const f32x4*)(gain + 32 * bj + 8 * fq + 4 * n);
            const int pos0 = row0 & (SEQ - 1);
            f32x4 cs[2], sn[2], c16[2], s16[2];
#pragma unroll
            for (int n = 0; n < 2; ++n) {
                cs[n] = *(const f32x4*)(ropeC + pos0 * 32 + 8 * fq + 4 * n); sn[n] = *(const f32x4*)(ropeS + pos0 * 32 + 8 * fq + 4 * n);
                c16[n] = *(const f32x4*)(rot + 8 * fq + 4 * n); s16[n] = *(const f32x4*)(rot + 32 + 8 * fq + 4 * n);
            }
#pragma unroll
            for (int ai = 0; ai < 2; ++ai) {
                if (ai == 1) {
#pragma unroll
                    for (int k = 0; k < 5; ++k)
#pragma unroll
                        for (int n = 0; n < 2; ++n) { const f32x4 c2 = cs[n] * c16[n] - sn[n] * s16[n]; sn[n] = sn[n] * c16[n] + cs[n] * s16[n]; cs[n] = c2; }
                }
#pragma unroll
                for (int m = 0; m < 4; ++m) {
                    const int row = row0 + ai * 128 + m * 16;
                    const float rs = rsv[ai * 4 + m];
                    float v[2][8];
#pragma unroll
                    for (int bj = 0; bj < 2; ++bj)
#pragma unroll
                        for (int e = 0; e < 8; ++e) v[bj][e] = acc[ai][bj][m][e >> 2][e & 3] * rs;
                    float ss = 0.f;
#pragma unroll
                    for (int bj = 0; bj < 2; ++bj)
#pragma unroll
                        for (int e = 0; e < 8; ++e) ss += v[bj][e] * v[bj][e];
                    ss += __shfl_xor(ss, 16); ss += __shfl_xor(ss, 32);
                    const float rn = __builtin_amdgcn_rsqf(ss * (1.0f / 64.0f) + EPS);
                    float o0[8], o1[8];
#pragma unroll
                    for (int e = 0; e < 8; ++e) {
                        const float cc = cs[e >> 2][e & 3], sv = sn[e >> 2][e & 3];
                        const float q0 = v[0][e] * rn * gv[0][e >> 2][e & 3], q1 = v[1][e] * rn * gv[1][e >> 2][e & 3];
                        o0[e] = (q0 * cc - q1 * sv) * oscale; o1[e] = (q1 * cc + q0 * sv) * oscale;
                    }
                    f16* p = (pn <= 1) ? Q + (size_t)row * 512 + (pn * 4 + wc) * 64 + 8 * fq : K + (size_t)row * 128 + wc * 64 + 8 * fq;
                    *(u32x4*)p = pack8(o0); *(u32x4*)(p + 32) = pack8(o1);
                    if (m < 3) {
#pragma unroll
                        for (int n = 0; n < 2; ++n) { const f32x4 c2 = cs[n] * c16[n] - sn[n] * s16[n]; sn[n] = sn[n] * c16[n] + cs[n] * s16[n]; cs[n] = c2; }
                    }
                }
            }
        } else {
#pragma unroll
            for (int ai = 0; ai < 2; ++ai)
#pragma unroll
                for (int m = 0; m < 4; ++m) {
                    const int row = row0 + ai * 128 + m * 16;
                    const float rs = rsv[ai * 4 + m];
                    float v[2][8];
#pragma unroll
                    for (int bj = 0; bj < 2; ++bj)
#pragma unroll
                        for (int e = 0; e < 8; ++e) v[bj][e] = acc[ai][bj][m][e >> 2][e & 3] * rs;
                    if (pn == 2) {
                        f16* p = V + (size_t)row * 128 + (wc - 2) * 64 + 8 * fq; *(u32x4*)p = pack8(v[0]); *(u32x4*)(p + 32) = pack8(v[1]);
                    } else if (pn <= 4) {
#pragma unroll
                        for (int bj = 0; bj < 2; ++bj)
#pragma unroll
                            for (int e = 0; e < 8; ++e) v[bj][e] = silu_f(v[bj][e]);
                        f16* p = GA + (size_t)row * 512 + (pn - 3) * 256 + wc * 64 + 8 * fq;
                        *(u32x4*)p = pack8(v[0]); *(u32x4*)(p + 32) = pack8(v[1]);
                    } else if (pn <= 6) {
#pragma unroll
                        for (int bj = 0; bj < 2; ++bj)
#pragma unroll
                            for (int e = 0; e < 8; ++e) v[bj][e] = silu_f(v[bj][e]);
                        const int gq = 2 * (pn - 5) + (wc >> 1), cg8 = 8 * (wc & 1) + fq;
                        f16* p = GF + ((size_t)(((row >> 12) * 4 + gq) * 16 + cg8) * 4096 + (row & 4095)) * 8;
                        *(u32x4*)p = pack8(v[0]); *(u32x4*)(p + (size_t)4 * 4096 * 8) = pack8(v[1]);
                    } else {
                        const int cg8 = 8 * (wc & 1) + fq;
                        f16* p = Z + (((size_t)(((row >> 12) * 4 + (pn - 7)) * 16 + cg8) * 4096 + (row & 4095)) * 2 + (wc >> 1)) * 8;
                        *(u32x4*)p = pack8(v[0]); *(u32x4*)(p + (size_t)4 * 4096 * 16) = pack8(v[1]);
                    }
                }
        }
    }
};

struct Epi2 {
    const float* __restrict__ xp; const float* __restrict__ xs; float* __restrict__ out; f16* XH; float* __restrict__ SS; int layer;
    __device__ __forceinline__ void prepare(LAS unsigned char*, const pg8::StaticOrder&, int) const {}
    __device__ __forceinline__ void operator()(const f32x4 (&acc)[2][2][4][2], const pg8::Unit& u, int, LAS unsigned char*, int wr, int wc, int fr_, int fq_) const {
        int fr = fr_, fq = fq_; asm volatile("" : "+v"(fr), "+v"(fq));
        const int row0 = u.pm * 256 + wr * 64 + fr, col0 = u.pn * 256 + wc * 64 + 8 * fq;
        if (layer == 0) {
#pragma unroll
            for (int ai = 0; ai < 2; ++ai) {
                f16x8 xh[4][2];
#pragma unroll
                for (int m = 0; m < 4; ++m)
#pragma unroll
                    for (int bj = 0; bj < 2; ++bj) xh[m][bj] = *(const f16x8*)(XH + (size_t)(row0 + ai * 128 + m * 16) * DM + col0 + bj * 32);
#pragma unroll
                for (int m = 0; m < 4; ++m) {
                    const int row = row0 + ai * 128 + m * 16;
                    float ss = 0.f;
#pragma unroll
                    for (int bj = 0; bj < 2; ++bj) {
                        f16x8 hv;
#pragma unroll
                        for (int e = 0; e < 8; ++e) { hv[e] = (f16)((float)xh[m][bj][e] + acc[ai][bj][m][e >> 2][e & 3]); const float tr = (float)hv[e]; ss += tr * tr; }
                        *(f16x8*)(XH + (size_t)row * DM + col0 + bj * 32) = hv;
                    }
                    ss += __shfl_xor(ss, 16); ss += __shfl_xor(ss, 32);
                    if (fq == 0) SS[(size_t)row * 16 + u.pn * 4 + wc] = ss;
                }
            }
        } else {
            f16x8 xh[2][4][2];
#pragma unroll
            for (int ai = 0; ai < 2; ++ai)
#pragma unroll
                for (int m = 0; m < 4; ++m)
#pragma unroll
                    for (int bj = 0; bj < 2; ++bj) xh[ai][m][bj] = *(const f16x8*)(XH + (size_t)(row0 + ai * 128 + m * 16) * DM + col0 + bj * 32);
#pragma unroll
            for (int ai = 0; ai < 2; ++ai)
#pragma unroll
                for (int m = 0; m < 4; ++m) {
                    float* dst = out + (size_t)(row0 + ai * 128 + m * 16) * DM + col0;
#pragma unroll
                    for (int bj = 0; bj < 2; ++bj) {
                        f32x4 x0, x1;
#pragma unroll
                        for (int e = 0; e < 4; ++e) { x0[e] = (float)xh[ai][m][bj][e] + acc[ai][bj][m][0][e]; x1[e] = (float)xh[ai][m][bj][4 + e] + acc[ai][bj][m][1][e]; }
                        *(f32x4*)(dst + bj * 32) = x0; *(f32x4*)(dst + bj * 32 + 4) = x1;
                    }
                }
        }
    }
};

__device__ void p0_mmat(const Args& a, LAS unsigned char* lds) {
    LAS float* ct = (LAS float*)lds; LAS float* st = ct + 128;
    int tid_ = threadIdx.x; asm volatile("" : "+v"(tid_)); const int tid = tid_;
    if (tid < 128) { float s, c; sincospif((float)tid * (1.0f / 64.0f), &s, &c); ct[tid] = c; st[tid] = s; }
    __syncthreads();
    float* MM = (float*)(a.ws + WS_MM);
    const int total = 2 * 4 * 128 * 64;
    for (int idx = blockIdx.x * NTHREADS + tid; idx < total; idx += gridDim.x * NTHREADS) {
        const int d4 = idx & 63, cp = (idx >> 6) & 127, lg = idx >> 13;
        const float* W = a.w_four + (size_t)lg * 128 * 128 + 4 * (d4 & 31);
        const LAS float* tb = (d4 < 32) ? ct : st;
        f32x4 acc = {0.f, 0.f, 0.f, 0.f};
#pragma unroll 8
        for (int c = 0; c < 128; ++c) acc += *(const f32x4*)(W + c * 128) * tb[(cp * c) & 127];
        *(f32x4*)(MM + ((size_t)(lg * 128 + cp) * 256 + 4 * d4)) = acc * 0.08838834764831845f;
    }
    __syncthreads();
}
__device__ void p0_rope(const Args& a) {
    float* rc = (float*)(a.ws + WS_ROPE); float* rsn = rc + 4096 * 32;
    for (int idx = blockIdx.x * NTHREADS + threadIdx.x; idx < 4096 * 32; idx += gridDim.x * NTHREADS) {
        const int i = idx & 31, pos = idx >> 5;
        const float inv_freq = 1.0f / powf(10000.0f, (float)i * (1.0f / 32.0f));
        const float ang = (float)pos * inv_freq;
        float s, c; sincosf(ang, &s, &c);
        rc[idx] = c; rsn[idx] = s;
    }
    if (blockIdx.x == 0 && threadIdx.x < 64) {
        float* rot = (float*)(a.ws + WS_ROT);
        const int i = threadIdx.x & 31, step = (threadIdx.x < 32) ? 16 : 128;
        const float inv_freq = 1.0f / powf(10000.0f, (float)i * (1.0f / 32.0f));
        float s, c; sincosf((float)step * inv_freq, &s, &c);
        rot[(threadIdx.x < 32 ? 0 : 64) + i] = c; rot[(threadIdx.x < 32 ? 32 : 96) + i] = s;
    }
}
__device__ void p0_xconv(const Args& a) {
    f16* XH = (f16*)(a.ws + WS_XH); float* SS = (float*)(a.ws + WS_SS);
    int tid_ = threadIdx.x; asm volatile("" : "+v"(tid_));
    const int lane = tid_ & 63, wv = tid_ >> 6;
    const int nwv = (int)gridDim.x * 8;
    for (int row0 = (int)blockIdx.x * 8 + wv; row0 < MROWS; row0 += 4 * nwv) {
        f32x4 v[4][4];
#pragma unroll
        for (int r = 0; r < 4; ++r) {
            const int row = row0 + r * nwv;
            if (row < MROWS) {
                const float* src = (row < ROWS_PROMPT) ? a.x_prompt + (size_t)row * DM : a.x_sample + (size_t)(row - ROWS_PROMPT) * DM;
#pragma unroll
                for (int i = 0; i < 4; ++i) v[r][i] = __builtin_nontemporal_load((const f32x4*)(src + i * 256 + lane * 4));
            }
        }
#pragma unroll
        for (int r = 0; r < 4; ++r) {
            const int row = row0 + r * nwv;
            if (row < MROWS) {
                float ss = 0.f;
#pragma unroll
                for (int i = 0; i < 4; ++i) {
                    const f32x4 x = v[r][i];
                    ss += (x[0] * x[0] + x[1] * x[1]) + (x[2] * x[2] + x[3] * x[3]);
                    f16x4 h; h[0] = (f16)x[0]; h[1] = (f16)x[1]; h[2] = (f16)x[2]; h[3] = (f16)x[3];
                    *(f16x4*)(XH + (size_t)row * DM + i * 256 + lane * 4) = h;
                }
#pragma unroll
                for (int o = 1; o < 64; o <<= 1) ss += __shfl_xor(ss, o);
                if (lane < 16) SS[(size_t)row * 16 + lane] = (lane == 0) ? ss : 0.f;
            }
        }
    }
}
__device__ void p_weights_plain(const Args& a) {
    int tid_ = threadIdx.x; asm volatile("" : "+v"(tid_)); const int tid = tid_;
    const int cq = tid & 63, rq = tid >> 6;
    const int lc0 = 4 * cq;
    const int rho0 = 128 * ((lc0 >> 5) & 1) + 32 * (lc0 >> 6) + 16 * ((lc0 >> 2) & 1) + 4 * ((lc0 >> 3) & 3);
    f16* W1T = (f16*)(a.ws + WS_W1T); f16* W2T = (f16*)(a.ws + WS_W2T);
    for (int u = blockIdx.x; u < 704; u += gridDim.x) {
        const float* w; f16* dst; int ldw, col; f32x4 gn = {1.f, 1.f, 1.f, 1.f};
        if (u < 448) {
            const int l = u / 224, r = u % 224, pn = r >> 5, kblk = r & 31, k0 = kblk * 32 + 4 * rq;
            const int L = pn * 256 + lc0; col = (L < 1280) ? L : L + 512; ldw = INW;
            w = a.w_in + (size_t)l * DM * INW + (size_t)k0 * INW;
            gn = *(const f32x4*)(a.norm_gain + l * DM + k0);
            dst = W1T + ((size_t)l * N1 + pn * 256 + rho0) * 1024 + k0;
        } else {
            const int r = u - 448, l = r >> 7, pn = (r >> 5) & 3, kblk = r & 31, k0 = kblk * 32 + 4 * rq;
            col = pn * 256 + lc0; ldw = DM;
            w = a.w_out + (size_t)l * DM * DM + (size_t)k0 * DM;
            dst = W2T + ((size_t)l * DM + pn * 256 + rho0) * 1024 + k0;
        }
        f32x4 x[4];
#pragma unroll
        for (int i = 0; i < 4; ++i) x[i] = *(const f32x4*)(w + (size_t)i * ldw + col) * gn[i];
#pragma unroll
        for (int j = 0; j < 4; ++j) {
            f16x4 o;
#pragma unroll
            for (int i = 0; i < 4; ++i) o[i] = (f16)x[i][j];
            *(f16x4*)(dst + (size_t)j * 1024) = o;
        }
    }
}
__device__ void p_weights_prod(const Args& a, LAS unsigned char* lds) {
    int tid_ = threadIdx.x; asm volatile("" : "+v"(tid_)); const int tid = tid_;
    const int cq = tid & 63, rq = tid >> 6;
    const int lc0 = 4 * cq;
    const int rho0 = 128 * ((lc0 >> 5) & 1) + 32 * (lc0 >> 6) + 16 * ((lc0 >> 2) & 1) + 4 * ((lc0 >> 3) & 3);
    f16* W1T = (f16*)(a.ws + WS_W1T); const float* MM = (const float*)(a.ws + WS_MM);
    LAS float* wt = (LAS float*)lds;
    LAS float* mmt = (LAS float*)(lds + 16384);
    for (int u = blockIdx.x; u < 256; u += gridDim.x) {
        const int l = u >> 7, g = (u >> 5) & 3, kblk = u & 31, pn = 7 + g;
        __syncthreads();
        {
            const int rr = tid >> 4, c8 = (tid & 15) * 8;
            const float* src = a.w_in + (size_t)l * DM * INW + (size_t)(kblk * 32 + rr) * INW + 1280 + g * 128 + c8;
            const f32x4* msrc = (const f32x4*)(MM + (size_t)(l * 4 + g) * 128 * 256) + tid;
            f32x4 mreg[16];
#pragma unroll
            for (int j = 0; j < 16; ++j) mreg[j] = msrc[j * NTHREADS];
            *(LAS f32x4*)(wt + rr * 128 + c8) = *(const f32x4*)src; *(LAS f32x4*)(wt + rr * 128 + c8 + 4) = *(const f32x4*)(src + 4);
#pragma unroll
            for (int j = 0; j < 16; ++j) ((LAS f32x4*)mmt)[tid + j * NTHREADS] = mreg[j];
        }
        __syncthreads();
        f32x4 acc[4];
#pragma unroll
        for (int r2 = 0; r2 < 4; ++r2) acc[r2] = (f32x4){0.f, 0.f, 0.f, 0.f};
#pragma unroll 2
        for (int c0 = 0; c0 < 128; c0 += 4) {
            f32x4 w4[4], m4[4];
#pragma unroll
            for (int r2 = 0; r2 < 4; ++r2) w4[r2] = *(const LAS f32x4*)(wt + (4 * rq + r2) * 128 + c0);
#pragma unroll
            for (int cc = 0; cc < 4; ++cc) m4[cc] = *(const LAS f32x4*)(mmt + (c0 + cc) * 256 + lc0);
#pragma unroll
            for (int r2 = 0; r2 < 4; ++r2)
#pragma unroll
                for (int cc = 0; cc < 4; ++cc) acc[r2] += m4[cc] * w4[r2][cc];
        }
        const int k0 = kblk * 32 + 4 * rq;
        const f32x4 gn = *(const f32x4*)(a.norm_gain + l * DM + k0);
#pragma unroll
        for (int j = 0; j < 4; ++j) {
            f16x4 o;
#pragma unroll
            for (int r2 = 0; r2 < 4; ++r2) o[r2] = (f16)(acc[r2][j] * gn[r2]);
            *(f16x4*)(W1T + ((size_t)l * N1 + pn * 256 + rho0 + j) * 1024 + k0) = o;
        }
    }
    __syncthreads();
}

typedef float f32x16 __attribute__((ext_vector_type(16)));
typedef short s16x4 __attribute__((ext_vector_type(4)));
__device__ __forceinline__ f16x8 tr_pair(LAS unsigned char* p0, LAS unsigned char* p1) {
    const s16x4 lo = __builtin_amdgcn_ds_read_tr16_b64_v4i16((LAS s16x4*)p0);
    const s16x4 hi = __builtin_amdgcn_ds_read_tr16_b64_v4i16((LAS s16x4*)p1);
    return __builtin_bit_cast(f16x8, __builtin_shufflevector(lo, hi, 0, 1, 2, 3, 4, 5, 6, 7));
}
__device__ __forceinline__ float max3f(float a, float b, float c) { float d; asm("v_max3_f32 %0, %1, %2, %3" : "=v"(d) : "v"(a), "v"(b), "v"(c)); return d; }
__device__ __forceinline__ f16x8 pack_p(const f32x16& p, int s) {
    f16x8 r;
#pragma unroll
    for (int j = 0; j < 8; ++j) r[j] = (f16)p[8 * s + j];
    return r;
}
__device__ void attn_phase(const Args& a, LAS unsigned char* lds, int layer) {
    int tid_ = threadIdx.x; asm volatile("" : "+v"(tid_)); const int tid = tid_;
    const int lane = tid & 63, wid = __builtin_amdgcn_readfirstlane(tid >> 6), r = lane & 31, h = lane >> 5;
    const int hq = wid >> 1, qh = wid & 1;
    const f16* Q = (const f16*)(a.ws + WS_Q); const f16* K = (const f16*)(a.ws + WS_K); const f16* V = (const f16*)(a.ws + WS_V);
    const f16* GA = (const f16*)(a.ws + WS_GA); f16* MIX = (f16*)(a.ws + WS_MIX);
    const int G = gridDim.x;
    int unit = blockIdx.x;
    if (unit >= 1536) return;
    float m0;
    {
        float gq = fabsf(a.qgain[layer * 64 + lane]), gk = fabsf(a.kgain[layer * 64 + lane]);
#pragma unroll
        for (int o = 1; o < 64; o <<= 1) { gq = fmaxf(gq, __shfl_xor(gq, o)); gk = fmaxf(gk, __shfl_xor(gk, o)); }
        m0 = __builtin_bit_cast(float, __builtin_amdgcn_readfirstlane(__builtin_bit_cast(int, 8.0f * gq * gk * LOG2E - 8.0f)));
    }
    u32x4 kreg[5], vreg[5];
#define ATT_LOAD(un) do { const int _qb = (un) & 63, _kvh = ((un) >> 6) & 1, _b = (un) >> 7, _q0 = _qb * 64; \
        _Pragma("unroll") for (int j = 0; j < 5; ++j) { const int i = tid + NTHREADS * j, rr = i >> 3, c = i & 7, kp0 = _q0 - 128 + rr, kp = kp0 < 0 ? 0 : (kp0 > SEQ - 1 ? SEQ - 1 : kp0); \
            const size_t off = ((size_t)(_b * SEQ + kp)) * 128 + _kvh * 64 + c * 8; kreg[j] = *(const u32x4*)(K + off); vreg[j] = *(const u32x4*)(V + off); } \
        } while (0)
    ATT_LOAD(unit);
    const int blk = (lane >> 4) & 1, tq = (lane & 15) >> 2, tp = lane & 3;
#pragma unroll 1
    for (; unit < 1536; unit += G) {
        const int qb = unit & 63, kvh = (unit >> 6) & 1, b = unit >> 7, q0 = qb * 64;
        const int head = kvh * 4 + hq, qp = q0 + 32 * qh + r;
        const size_t grow = (size_t)(b * SEQ + qp);
        f16x8 qf[4];
#pragma unroll
        for (int s = 0; s < 4; ++s) qf[s] = *(const f16x8*)(Q + grow * 512 + head * 64 + 16 * s + 8 * h);
        const float sinkv = a.sink[layer * 8 + head];
        __syncthreads();
#pragma unroll
        for (int j = 0; j < 5; ++j) {
            const int i = tid + NTHREADS * j, rr = i >> 3, c = i & 7;
            *(LAS u32x4*)(lds + rr * 128 + ((c ^ ((rr >> 1) & 7)) << 4)) = kreg[j];
            *(LAS u32x4*)(lds + 40960 + rr * 128 + (((c >> 1) ^ (rr & 3)) << 5) + ((c & 1) << 4)) = vreg[j];
        }
        __syncthreads();
        { const int un = (unit + G < 1536) ? unit + G : unit; ATT_LOAD(un); }
        f32x16 O0, O1;
#pragma unroll
        for (int i = 0; i < 16; ++i) { O0[i] = 0.f; O1[i] = 0.f; }
        float l = h ? 0.0f : __builtin_amdgcn_exp2f(sinkv * LOG2E - m0);
        const int lo_d = (-qp > -128) ? -qp : -128, hi_d = (SEQ - 1 - qp < 128) ? (SEQ - 1 - qp) : 128;
        const int ksw = (r >> 1) & 7;
        LAS unsigned char* kbase = lds + r * 128 + qh * 4096;
        LAS unsigned char* vbase = lds + 40960 + (4 * h + tq) * 128 + tp * 8 + qh * 4096;
        const int vsw0 = ((0 + blk) ^ tq) << 5, vsw1 = ((2 + blk) ^ tq) << 5;
        const int dbase = q0 - 128 + 32 * qh + 4 * h - qp;
        f16x8 kf[4];
#define ATT_KREAD(j_) do { _Pragma("unroll") for (int s = 0; s < 4; ++s) kf[s] = *(const LAS f16x8*)(kbase + (j_) * 4096 + (((2 * s + h) ^ ksw) << 4)); } while (0)
        f32x16 A;
#pragma unroll
        for (int i = 0; i < 16; ++i) A[i] = -m0;
        ATT_KREAD(0);
#pragma unroll
        for (int s = 0; s < 4; ++s) A = __builtin_amdgcn_mfma_f32_32x32x16_f16(kf[s], qf[s], A, 0, 0, 0);
        u32x4 gw[2][2];
#pragma unroll 1
        for (int j = 0; j < 9; ++j) {
            f32x16 S = A;
            if (j < 8) ATT_KREAD(j + 1);
            f16x8 vf[2][2];
#pragma unroll
            for (int sp = 0; sp < 2; ++sp) {
                LAS unsigned char* va = vbase + (32 * j + 16 * sp) * 128;
                vf[sp][0] = tr_pair(va + vsw0, va + 1024 + vsw0);
                vf[sp][1] = tr_pair(va + vsw1, va + 1024 + vsw1);
            }
            __builtin_amdgcn_sched_barrier(0);
            if (j < 8) {
#pragma unroll
                for (int i = 0; i < 16; ++i) A[i] = -m0;
#pragma unroll
                for (int s = 0; s < 4; ++s) A = __builtin_amdgcn_mfma_f32_32x32x16_f16(kf[s], qf[s], A, 0, 0, 0);
            }
            if (j == 7) {
#pragma unroll
                for (int dt = 0; dt < 2; ++dt)
#pragma unroll
                    for (int kk = 0; kk < 2; ++kk) gw[dt][kk] = *(const u32x4*)(GA + grow * 512 + head * 64 + 32 * dt + 8 * (2 * kk + h));
            }
            __builtin_amdgcn_sched_barrier(0);
            const int k0s = q0 - 128 + 32 * (qh + j);
            if (j == 0 || j == 8 || k0s < 0 || k0s + 32 > SEQ) {
                const int base = dbase + 32 * j;
#pragma unroll
                for (int i = 0; i < 16; ++i) { const int d0 = base + (i & 3) + 8 * (i >> 2); if (d0 < lo_d || d0 > hi_d) S[i] = -1e30f; }
            }

#pragma unroll
            for (int i = 0; i < 16; ++i) S[i] = __builtin_amdgcn_exp2f(S[i]);
            l += ((S[0] + S[1]) + (S[2] + S[3])) + ((S[4] + S[5]) + (S[6] + S[7])) + (((S[8] + S[9]) + (S[10] + S[11])) + ((S[12] + S[13]) + (S[14] + S[15])));
#pragma unroll
            for (int sp = 0; sp < 2; ++sp) {
                const f16x8 pf = pack_p(S, sp);
                O0 = __builtin_amdgcn_mfma_f32_32x32x16_f16(vf[sp][0], pf, O0, 0, 0, 0);
                O1 = __builtin_amdgcn_mfma_f32_32x32x16_f16(vf[sp][1], pf, O1, 0, 0, 0);
            }
        }
#undef ATT_KREAD
        const float inv = 1.0f / (l + __shfl_xor(l, 32));
#pragma unroll
        for (int dt = 0; dt < 2; ++dt)
#pragma unroll
            for (int kk = 0; kk < 2; ++kk) {
                u32x2 glo = {gw[dt][kk][0], gw[dt][kk][1]}, ghi = {gw[dt][kk][2], gw[dt][kk][3]};
#pragma unroll
                for (int w2 = 0; w2 < 2; ++w2) { const auto sw = __builtin_amdgcn_permlane32_swap(glo[w2], ghi[w2], false, false); glo[w2] = sw[0]; ghi[w2] = sw[1]; }
                const f16x4 g0 = __builtin_bit_cast(f16x4, glo), g1 = __builtin_bit_cast(f16x4, ghi);
                f16x4 o0, o1;
#pragma unroll
                for (int j = 0; j < 4; ++j) {
                    o0[j] = (f16)((dt ? O1[8 * kk + j] : O0[8 * kk + j]) * inv * (float)g0[j]);
                    o1[j] = (f16)((dt ? O1[8 * kk + 4 + j] : O0[8 * kk + 4 + j]) * inv * (float)g1[j]);
                }
                u32x2 a0 = __builtin_bit_cast(u32x2, o0), a1 = __builtin_bit_cast(u32x2, o1);
#pragma unroll
                for (int w2 = 0; w2 < 2; ++w2) { const auto sw = __builtin_amdgcn_permlane32_swap(a0[w2], a1[w2], false, false); a0[w2] = sw[0]; a1[w2] = sw[1]; }
                const u32x4 st = {a0[0], a0[1], a1[0], a1[1]};
                *(u32x4*)(MIX + grow * 1024 + head * 64 + 32 * dt + 8 * (2 * kk + h)) = st;
            }
    }
#undef ATT_LOAD
}

__device__ void fft_tables(LAS unsigned char* lds) {
    LAS f16* CF = (LAS f16*)(lds + LDS_TAB); LAS f16* SF = CF + 4096; LAS f16* NSF = SF + 4096;
    for (int e = threadIdx.x; e < 4096; e += NTHREADS) {
        const int jj = e & 7, lane = (e >> 3) & 63, kt = (e >> 9) & 1, s = e >> 10, h = lane >> 5;
        const int n = 16 * s + 8 * (jj >> 2) + 4 * h + (jj & 3), k = 32 * kt + (lane & 31);
        float sn, cs; sincospif((float)((n * k) & 63) * (1.0f / 32.0f), &sn, &cs);
        CF[e] = (f16)(cs * 0.125f); SF[e] = (f16)(sn * 0.125f); NSF[e] = (f16)(-sn * 0.125f);
    }
}
__device__ void p0_twiddle(const Args& a) {
    f32x2* TW = (f32x2*)(a.ws + WS_TW);
    for (int idx = blockIdx.x * NTHREADS + threadIdx.x; idx < 4096; idx += gridDim.x * NTHREADS) {
        const int lane = idx & 63, reg = (idx >> 6) & 15, kt = (idx >> 10) & 1, mt = idx >> 11, h = lane >> 5;
        const int n2 = 32 * mt + (reg & 3) + 8 * (reg >> 2) + 4 * h, k1 = 32 * kt + (lane & 31);
        float sn, cs; sincospif((float)(n2 * k1) * (1.0f / 2048.0f), &sn, &cs);
        TW[((((mt * 2 + kt) * 8 + (reg >> 1)) * 64 + lane) << 1) + (reg & 1)] = (f32x2){cs, sn};
    }
}
__device__ void fft_phase(const Args& a, LAS unsigned char* lds) {
    int tid_ = threadIdx.x; asm volatile("" : "+v"(tid_)); const int tid = tid_;
    const int lane = tid & 63, wid = __builtin_amdgcn_readfirstlane(tid >> 6), r = lane & 31, h = lane >> 5;
    const f16* Z = (const f16*)(a.ws + WS_Z); const f16* GF = (const f16*)(a.ws + WS_GF);
    const f32x2* TW = (const f32x2*)(a.ws + WS_TW);
    f16* FOUR = (f16*)(a.ws + WS_FOUR);
    const int G = gridDim.x;
    int unit = blockIdx.x;
    if (unit >= 768) return;
    f16x8 pin[4][4];
#define FFT_LOAD(un) do { const size_t _b0 = (size_t)(((un) >> 6) * 4 + (((un) >> 4) & 3)) * 16 + ((un) & 15); \
        int _tl = tid; asm volatile("" : "+v"(_tl)); \
        _Pragma("unroll") for (int it = 0; it < 4; ++it) { const f16* zp = Z + (_b0 * 4096 + 2 * (_tl + NTHREADS * it)) * 16; \
            _Pragma("unroll") for (int q = 0; q < 4; ++q) pin[it][q] = *(const f16x8*)(zp + 8 * q); } } while (0)
    FFT_LOAD(unit);
#pragma unroll 1
    for (; unit < 768; unit += G) {
    const int cg8 = unit & 15, g = (unit >> 4) & 3, b = unit >> 6;
    const size_t blk0 = (size_t)((b * 4 + g) * 16 + cg8) * 4096;
    __syncthreads();
#pragma unroll
    for (int it = 0; it < 4; ++it) {
        const int token = 2 * (tid + NTHREADS * it);
        const int n1 = token >> 6, n2 = token & 63;
        const int off = n1 * 128 + (((n2 >> 4) ^ (n1 & 3)) << 5) + (n2 & 15) * 2;
#pragma unroll
        for (int ch = 0; ch < 8; ++ch) {
            *(LAS f16x2*)(lds + ch * 16384 + off) = (f16x2){pin[it][0][ch], pin[it][2][ch]};
            *(LAS f16x2*)(lds + ch * 16384 + 8192 + off) = (f16x2){pin[it][1][ch], pin[it][3][ch]};
        }
    }
    __syncthreads();
    LAS unsigned char* img = lds + wid * 16384;
    const LAS f16x8* CF = (const LAS f16x8*)(lds + LDS_TAB) + lane; const LAS f16x8* SF = CF + 512; const LAS f16x8* NSF = SF + 512;
    const int blk = (lane >> 4) & 1, tq = (lane & 15) >> 2, tp = lane & 3;
    f32x16 X[2][2];
#pragma unroll
    for (int i = 0; i < 2; ++i)
#pragma unroll
        for (int j = 0; j < 2; ++j)
#pragma unroll
            for (int e = 0; e < 16; ++e) X[i][j][e] = 0.f;
#pragma unroll
    for (int mt = 0; mt < 2; ++mt) {
        f32x16 Yr[2], Yi[2];
#pragma unroll
        for (int j = 0; j < 2; ++j)
#pragma unroll
            for (int e = 0; e < 16; ++e) { Yr[j][e] = 0.f; Yi[j][e] = 0.f; }
#pragma unroll
        for (int which = 0; which < 2; ++which)
#pragma unroll
            for (int s = 0; s < 4; ++s) {
                LAS unsigned char* pa = img + which * 8192 + (16 * s + 4 * h + tq) * 128 + (((2 * mt + blk) ^ tq) << 5) + tp * 8;
                const f16x8 af = tr_pair(pa, pa + 8 * 128);
#pragma unroll
                for (int kt = 0; kt < 2; ++kt) {
                    const f16x8 cf = CF[(s * 2 + kt) * 64], sf = which ? NSF[(s * 2 + kt) * 64] : SF[(s * 2 + kt) * 64];
                    if (which == 0) { Yr[kt] = __builtin_amdgcn_mfma_f32_32x32x16_f16(af, cf, Yr[kt], 0, 0, 0); Yi[kt] = __builtin_amdgcn_mfma_f32_32x32x16_f16(af, sf, Yi[kt], 0, 0, 0); }
                    else { Yr[kt] = __builtin_amdgcn_mfma_f32_32x32x16_f16(af, sf, Yr[kt], 0, 0, 0); Yi[kt] = __builtin_amdgcn_mfma_f32_32x32x16_f16(af, cf, Yi[kt], 0, 0, 0); }
                }
            }
        f16x8 trf[2][2], tif[2][2];
#pragma unroll
        for (int kt = 0; kt < 2; ++kt) {
            int lane_l = lane; asm volatile("" : "+v"(lane_l));
            const f32x4* tw = (const f32x4*)TW + ((mt * 2 + kt) * 8) * 64 + lane_l;
            f32x16 tr, ti;
#pragma unroll
            for (int p = 0; p < 8; ++p) { const f32x4 cs = tw[p * 64];
                tr[2 * p] = Yr[kt][2 * p] * cs[0] - Yi[kt][2 * p] * cs[1]; ti[2 * p] = Yr[kt][2 * p] * cs[1] + Yi[kt][2 * p] * cs[0];
                tr[2 * p + 1] = Yr[kt][2 * p + 1] * cs[2] - Yi[kt][2 * p + 1] * cs[3]; ti[2 * p + 1] = Yr[kt][2 * p + 1] * cs[3] + Yi[kt][2 * p + 1] * cs[2]; }
#pragma unroll
            for (int sp = 0; sp < 2; ++sp) { trf[kt][sp] = pack_p(tr, sp); tif[kt][sp] = pack_p(ti, sp); }
        }
#pragma unroll
        for (int sp = 0; sp < 2; ++sp)
#pragma unroll
            for (int mt2 = 0; mt2 < 2; ++mt2) {
                const f16x8 cf = CF[((2 * mt + sp) * 2 + mt2) * 64], nsf = NSF[((2 * mt + sp) * 2 + mt2) * 64];
#pragma unroll
                for (int kt = 0; kt < 2; ++kt) {
                    X[mt2][kt] = __builtin_amdgcn_mfma_f32_32x32x16_f16(cf, trf[kt][sp], X[mt2][kt], 0, 0, 0);
                    X[mt2][kt] = __builtin_amdgcn_mfma_f32_32x32x16_f16(nsf, tif[kt][sp], X[mt2][kt], 0, 0, 0);
                }
            }
    }
#pragma unroll
    for (int mt2 = 0; mt2 < 2; ++mt2)
#pragma unroll
        for (int kt = 0; kt < 2; ++kt)
#pragma unroll
            for (int e = 0; e < 16; ++e) {
                const int token = 32 * kt + r + 64 * (32 * mt2 + (e & 3) + 8 * (e >> 2) + 4 * h);
                *(LAS f16*)(img + token * 2) = (f16)X[mt2][kt][e];
            }
    f16x8 gt[4][2];
    int tl = tid; asm volatile("" : "+v"(tl));
#pragma unroll
    for (int it = 0; it < 4; ++it) { const f16* gp = GF + (blk0 + 2 * (tl + NTHREADS * it)) * 8; gt[it][0] = *(const f16x8*)gp; gt[it][1] = *(const f16x8*)(gp + 8); }
    { const int un = (unit + G < 768) ? unit + G : unit; FFT_LOAD(un); }
    __syncthreads();
#pragma unroll
    for (int it = 0; it < 4; ++it) {
        const int token = 2 * (tl + NTHREADS * it);
        f16x8 o0, o1;
#pragma unroll
        for (int ch = 0; ch < 8; ++ch) {
            const f16x2 v = *(const LAS f16x2*)(lds + ch * 16384 + token * 2);
            o0[ch] = (f16)((float)v[0] * (float)gt[it][0][ch]); o1[ch] = (f16)((float)v[1] * (float)gt[it][1][ch]);
        }
        *(f16x8*)(FOUR + (blk0 + token) * 8) = o0; *(f16x8*)(FOUR + (blk0 + token) * 8 + 8) = o1;
    }
    }
#undef FFT_LOAD
}

#define XB_TMO      128
#define XB_XCNT(j)  (256  + 64 * (j))
#define XB_XSUB(j)  (1280 + 64 * (j))
#define XB_XGEN(j)  (2304 + 64 * (j))
#define XB_TOP      3328
#define XB_TOPGEN   3392
#define XCD_BAR_WORDS 3456
#define XB_SPIN_CAP (1u << 18)
__device__ __forceinline__ unsigned xb_ld(unsigned* p)              { return __hip_atomic_load(p, __ATOMIC_RELAXED, __HIP_MEMORY_SCOPE_AGENT); }
__device__ __forceinline__ unsigned xb_add(unsigned* p, unsigned v) { return __hip_atomic_fetch_add(p, v, __ATOMIC_RELAXED, __HIP_MEMORY_SCOPE_AGENT); }
__device__ __forceinline__ unsigned xb_xcc_id() { return (unsigned)__builtin_amdgcn_s_getreg((3 << 11) | 20) & 0xFu; }
#define XB_SPIN(cond, bar) do { unsigned _sp = 0; while (cond) { __builtin_amdgcn_s_sleep(1); \
    if ((++_sp & 255u) == 0u) { if (xb_ld(&(bar)[XB_TMO])) break; if (_sp > XB_SPIN_CAP) { atomicAdd(&(bar)[XB_TMO], 1u); break; } } } } while (0)
struct XcdBarrier { unsigned* bar; unsigned x; volatile LAS unsigned* st; };
__device__ __forceinline__ XcdBarrier xcd_barrier_post(unsigned* bar, volatile LAS unsigned* st) {
    XcdBarrier b; b.bar = bar; b.x = xb_xcc_id(); b.st = st;
    if (threadIdx.x == 0) (void)xb_add(&bar[XB_XCNT(b.x)], 1u);
    return b;
}
__device__ __forceinline__ void xcd_barrier_complete(unsigned* bar, unsigned x, unsigned& nloc, unsigned& nx) {
    const unsigned G = gridDim.x * gridDim.y * gridDim.z;
    unsigned sum, cnt, mine, sp = 0u;
    for (;;) {
        sum = 0u; cnt = 0u; mine = 0u;
#pragma unroll 1
        for (unsigned j = 0; j < 16; ++j) { const unsigned c = xb_ld(&bar[XB_XCNT(j)]); sum += c; cnt += (c > 0u) ? 1u : 0u; mine = (j == x) ? c : mine; }
        if (sum == G) break;
        __builtin_amdgcn_s_sleep(1);
        if ((++sp & 255u) == 0u) { if (xb_ld(&bar[XB_TMO])) break; if (sp > XB_SPIN_CAP) { atomicAdd(&bar[XB_TMO], 1u); break; } }
    }
    nloc = mine > 0u ? mine : 1u; nx = cnt > 0u ? cnt : 1u;
}
__device__ __forceinline__ void xcd_barrier(const XcdBarrier& b) {
    asm volatile("s_waitcnt vmcnt(0)" ::: "memory");
    __syncthreads();
    if (threadIdx.x == 0) {
        unsigned* bar = b.bar; asm volatile("" : "+s"(bar));
        __builtin_amdgcn_s_waitcnt(0);
        unsigned nloc = b.st[0], nx = b.st[1];
        if (nloc == 0u) { xcd_barrier_complete(bar, b.x, nloc, nx); b.st[0] = nloc; b.st[1] = nx; }
        const unsigned old = xb_add(&bar[XB_XSUB(b.x)], 1u);
        const unsigned gen = old / nloc;
        if (old + 1u == (gen + 1u) * nloc) {
            __builtin_amdgcn_fence(__ATOMIC_RELEASE, "agent");
            asm volatile("s_waitcnt vmcnt(0)" ::: "memory");
            const unsigned og = xb_add(&bar[XB_TOP], 1u);
            const unsigned tg = og / nx;
            if (og + 1u == (tg + 1u) * nx) xb_add(&bar[XB_TOPGEN], 1u);
            else XB_SPIN(xb_ld(&bar[XB_TOPGEN]) == tg, bar);
            __builtin_amdgcn_fence(__ATOMIC_ACQUIRE, "agent");
            xb_add(&bar[XB_XGEN(b.x)], 1u);
            asm volatile("s_waitcnt vmcnt(0)" ::: "memory");
        } else {
            XB_SPIN(xb_ld(&bar[XB_XGEN(b.x)]) == gen, bar);
            __builtin_amdgcn_fence(__ATOMIC_ACQUIRE, "agent");
            asm volatile("s_waitcnt vmcnt(0)" ::: "memory");
        }
    }
    __syncthreads();
}

__global__ void __launch_bounds__(NTHREADS, 2) hymba_fwd(Args a) {
    extern __shared__ __attribute__((aligned(16))) unsigned char lds_raw[];
    LAS unsigned char* lds = (LAS unsigned char*)lds_raw;
    if (threadIdx.x < 2) ((volatile LAS unsigned*)(lds + LDS_MISC))[threadIdx.x] = 0u;
    __syncthreads();
    const XcdBarrier bar = xcd_barrier_post((unsigned*)(a.ws + WS_BAR), (volatile LAS unsigned*)(lds + LDS_MISC));
    const int lo = a.ph_lo, hi = a.ph_hi;
#define IN(k) (lo <= (k) && (k) < hi)
#define SEAM(k) do { if (IN(k) && IN((k) + 1)) xcd_barrier(bar); } while (0)
    if (IN(0)) { p0_mmat(a, lds); p0_rope(a); p0_twiddle(a); p_weights_plain(a); }
    SEAM(0);
    if (IN(1)) { p_weights_prod(a, lds); p0_xconv(a); }
    fft_tables(lds);
    SEAM(1);
#pragma unroll 1
    for (int layer = 0; layer < 2; ++layer) {
        const int pb = 2 + 3 * layer;
        if (IN(pb)) {
            pg8::Gemm g{(const f16*)(a.ws + WS_XH), (const f16*)(a.ws + WS_W1T) + (size_t)layer * N1 * 1024, MROWS, N1, 1024, nullptr};
            pg8::StaticOrder S; S.init(MROWS, N1, gridDim.x, blockIdx.x);
            const bool split = (gridDim.x == 256);
            if (split) S.hi = 2048;
            Epi1 E{a.ws, a.qgain + layer * 64, a.kgain + layer * 64};
            pg8::gemm_phase<Epi1, false>(lds, g, S, E);
            if (split) {
                unsigned* tailq = (unsigned*)(a.ws + WS_BAR) + 3584 + 64 * layer;
                volatile LAS unsigned* qslot = (volatile LAS unsigned*)(lds + LDS_MISC) + 8;
                for (;;) {
                    if (threadIdx.x == 0) *qslot = __hip_atomic_fetch_add(tailq, 1u, __ATOMIC_RELAXED, __HIP_MEMORY_SCOPE_AGENT);
                    __syncthreads();
                    const unsigned q = *qslot;
                    __syncthreads();
                    if (q >= 256u) break;
                    pg8::Unit tu; S.unit_of(2048 + (int)(q >> 2), tu);
                    gemm1_tail_quadrant(lds, g.A, g.Bt, a.ws, tu.pm, tu.pn, (int)((q >> 1) & 1u), (int)(q & 1u));
                }
            }
        }
        SEAM(pb);
        if (IN(pb + 1)) {
#pragma unroll 1
            for (int part = 0; part < 2; ++part) {
                if ((part ^ (int)((blockIdx.x >> 3) & 1)) == 0) attn_phase(a, lds, layer);
                else fft_phase(a, lds);
            }
        }
        SEAM(pb + 1);
        if (IN(pb + 2)) {
            pg8::Gemm g{(const f16*)(a.ws + WS_MIX), (const f16*)(a.ws + WS_W2T) + (size_t)layer * 1024 * 1024, MROWS, 1024, 1024, (const f16*)(a.ws + WS_FOUR)};
            pg8::StaticOrder S; S.init(MROWS, 1024, gridDim.x, blockIdx.x);
            Epi2 E{a.x_prompt, a.x_sample, a.out, (f16*)(a.ws + WS_XH), (float*)(a.ws + WS_SS), layer};
            pg8::gemm_phase<Epi2, true>(lds, g, S, E);
        }
        if (layer == 0) SEAM(pb + 2);
    }
#undef IN
#undef SEAM
}

extern "C" void kernel_launch(void* const* d_in, const int* in_sizes, int n_in, void* d_out, int out_size, void* d_ws, size_t ws_size, hipStream_t stream) {
    static int grid = 0;
    if (grid == 0) {
        int dev = 0, cus = 0, per_cu = 0;
        hipGetDevice(&dev);
        hipDeviceGetAttribute(&cus, hipDeviceAttributeMultiprocessorCount, dev);
        hipFuncSetAttribute((const void*)hymba_fwd, hipFuncAttributeMaxDynamicSharedMemorySize, LDS_BYTES);
        hipOccupancyMaxActiveBlocksPerMultiprocessor(&per_cu, (const void*)hymba_fwd, NTHREADS, LDS_BYTES);
        if (per_cu < 1) { fprintf(stderr, "kernel_launch: occupancy query says %d blocks/CU\n", per_cu); per_cu = 1; }
        if (per_cu > 1) per_cu = 1;
        grid = cus * per_cu;
        if (ws_size < WS_END) { fprintf(stderr, "kernel_launch: workspace too small (%zu < %zu)\n", ws_size, (size_t)WS_END); grid = -1; }
    }
    if (grid < 0) return;
    hipMemsetAsync((char*)d_ws + WS_BAR, 0, 16384, stream);
    Args a{};
    a.x_prompt = (const float*)d_in[0]; a.x_sample = (const float*)d_in[1]; a.norm_gain = (const float*)d_in[2]; a.w_in = (const float*)d_in[3];
    a.qgain = (const float*)d_in[4]; a.kgain = (const float*)d_in[5]; a.sink = (const float*)d_in[6]; a.w_four = (const float*)d_in[7]; a.w_out = (const float*)d_in[8];
    a.out = (float*)d_out; a.ws = (unsigned char*)d_ws; a.ph_lo = 0; a.ph_hi = 8;
    void* args[] = {&a};
    hipError_t e = hipLaunchCooperativeKernel((const void*)hymba_fwd, dim3(grid), dim3(NTHREADS), args, LDS_BYTES, stream);
    if (e != hipSuccess) fprintf(stderr, "kernel_launch: cooperative launch failed: %s (grid %d)\n", hipGetErrorString(e), grid);
}
```

```cpp
#include <hip/hip_runtime.h>
#include <cstdio>
#include <cstdint>

#define LAS __attribute__((address_space(3)))
typedef _Float16 f16;
typedef _Float16 f16x8 __attribute__((ext_vector_type(8)));
typedef _Float16 f16x4 __attribute__((ext_vector_type(4)));
typedef _Float16 f16x2 __attribute__((ext_vector_type(2)));
typedef float f32x4 __attribute__((ext_vector_type(4)));
typedef float f32x2 __attribute__((ext_vector_type(2)));
typedef unsigned u32x4 __attribute__((ext_vector_type(4)));
typedef unsigned u32x2 __attribute__((ext_vector_type(2)));

constexpr int SEQ = 4096, NBATCH = 12, MROWS = NBATCH * SEQ  , DM = 1024, INW = 2304, N1 = 2816;
constexpr int ROWS_PROMPT = 4 * SEQ;
constexpr float EPS = 1e-6f;
constexpr float LOG2E = 1.4426950408889634f;
constexpr int NTHREADS = 512;
constexpr int LDS_RS = 152 * 1024 + 256;
constexpr int LDS_BYTES = LDS_RS + 9 * 256 * 2;
constexpr int LDS_MISC = 152 * 1024;
constexpr int LDS_TAB = 128 * 1024;

constexpr size_t SZ_XH = (size_t)MROWS * 1024 * 2, SZ_Q = (size_t)MROWS * 512 * 2, SZ_KV = (size_t)MROWS * 128 * 2;
constexpr size_t WS_XH = 0;
constexpr size_t WS_Q = WS_XH + SZ_XH;
constexpr size_t WS_K = WS_Q + SZ_Q;
constexpr size_t WS_V = WS_K + SZ_KV;
constexpr size_t WS_GA = WS_V + SZ_KV;
constexpr size_t WS_GF = WS_GA + SZ_Q;
constexpr size_t WS_Z = WS_GF + SZ_Q;
constexpr size_t WS_MIX = WS_Z + SZ_XH;
constexpr size_t WS_FOUR = WS_MIX + SZ_XH;
constexpr size_t WS_SS = WS_FOUR + SZ_Q;
constexpr size_t WS_W1T = WS_SS + (size_t)MROWS * 16 * 4;
constexpr size_t WS_W2T = WS_W1T + (size_t)2 * N1 * 1024 * 2;
constexpr size_t WS_MM = WS_W2T + (size_t)2 * 1024 * 1024 * 2;
constexpr size_t WS_ROPE = WS_MM + (size_t)2 * 4 * 128 * 256 * 4;
constexpr size_t WS_TW = WS_ROPE + (size_t)2 * 4096 * 32 * 4;
constexpr size_t WS_ROT = WS_TW + (size_t)4096 * 8;
constexpr size_t WS_BAR = WS_ROT + 1024;
constexpr size_t WS_END = WS_BAR + 16384;

struct Args {
    const float* x_prompt; const float* x_sample; const float* norm_gain; const float* w_in; const float* qgain; const float* kgain;
    const float* sink; const float* w_four; const float* w_out; float* out; unsigned char* ws; int ph_lo, ph_hi;
};

namespace pg8 {
constexpr int BM = 256, BK = 64, HALF = 128, HTB = HALF * BK * 2, STAGE_BYTES = 8 * HTB, NXCD = 8, WGM = 4;
__device__ __forceinline__ int lds_byte(int r, int c) { const int st = (r >> 4) * 2 + (c >> 5), rr = r & 15, cc = c & 31, ob = rr * 64 + cc * 2; return st * 1024 + (ob ^ (((ob >> 9) & 1) << 5)); }
__device__ __forceinline__ void stage_rc(int b, int& R, int& C) { const int st = b / 1024, sb = b % 1024, swz = sb ^ (((sb >> 9) & 1) << 5); R = (st >> 1) * 16 + swz / 64; C = (st & 1) * 32 + (swz % 64) / 2; }
struct Unit { int pm, pn; };
struct Gemm { const f16* A; const f16* Bt; int M, N, K; const f16* A2; };
struct StaticOrder {
    int nM, nN, nwg, G, c, hi;
    __device__ void init(int M, int N, int G_, int c_) { nM = M / BM; nN = N / BM; nwg = nM * nN; G = G_; c = c_; hi = nwg; }
    __device__ bool next(int i, Unit& u) const { const long L = (long)i * G + c; if (L >= hi) return false; unit_of((int)L, u); return true; }
    __device__ void unit_of(int L, Unit& u) const {
        int wgid = L; { const int q = nwg / NXCD, r = nwg % NXCD, xcd = wgid % NXCD, off = wgid / NXCD; wgid = (xcd < r ? xcd * (q + 1) : r * (q + 1) + (xcd - r) * q) + off; }
        const int nig = WGM * nN, gid = wgid / nig, fm = gid * WGM, gsz = (nM - fm) < WGM ? (nM - fm) : WGM;
        u.pm = fm + ((wgid % nig) % gsz); u.pn = (wgid % nig) / gsz;
    }
};

template <class Epi, bool SPLITA>
__device__ __forceinline__ void gemm_phase(LAS unsigned char* lds, const Gemm g, const StaticOrder& S, const Epi& E) {
    int tid_ = threadIdx.x; asm volatile("" : "+v"(tid_));
    const int tid = tid_, wid = __builtin_amdgcn_readfirstlane(tid >> 6), lane = tid & 63, wr = wid >> 2, wc = wid & 3, fr = lane & 15, fq = lane >> 4;
    const int K = g.K, nt = K / BK;
    unsigned voffA[2], voffF[2];
#pragma unroll
    for (int i = 0; i < 2; ++i) { int R, C; stage_rc(tid * 16 + i * 8192, R, C); voffA[i] = (unsigned)(R * K + C) * 2u; voffF[i] = (unsigned)((C >> 3) * 65536 + R * 16); }
    const size_t kstep = (size_t)(BK * 2);
    const size_t hstep = (size_t)HALF * K * 2;
    const size_t tstep = 2 * hstep;
    const unsigned ldsw = (unsigned)wid * 1024u;
    const int aoff = lds_byte(wr * 64 + fr, fq * 8), boff = lds_byte(wc * 32 + fr, fq * 8);
#define PG8_SA(b, h) (((b) * 2 + (h)) * HTB)
#define PG8_SB(b, h) ((4 + (b) * 2 + (h)) * HTB)
#define PG8_STAGE(bufoff, gbase) do { _Pragma("unroll") for (int _i = 0; _i < 2; ++_i) \
        __builtin_amdgcn_global_load_lds((const unsigned*)((const char*)(gbase) + voffA[_i]), (LAS unsigned*)(lds + (bufoff) + ldsw + _i * 8192), 16, 0, 0); } while (0)
#define PG8_STAGE_A(bufoff, pm_, kt_, half_) do { const char* _b; unsigned _v0, _v1; \
        if (SPLITA && (kt_) >= 8) { const int _k2 = (kt_) - 8; _b = (const char*)g.A2 + ((size_t)(((((pm_) >> 4) * 4 + (_k2 >> 1)) * 16 + (_k2 & 1) * 8)) * 4096 + ((pm_) & 15) * 256 + (half_) * 128) * 16; _v0 = voffF[0]; _v1 = voffF[1]; } \
        else { _b = (const char*)g.A + (size_t)(pm_) * tstep + (size_t)(half_) * hstep + (size_t)(kt_) * kstep; _v0 = voffA[0]; _v1 = voffA[1]; } \
        __builtin_amdgcn_global_load_lds((const unsigned*)(_b + _v0), (LAS unsigned*)(lds + (bufoff) + ldsw), 16, 0, 0); \
        __builtin_amdgcn_global_load_lds((const unsigned*)(_b + _v1), (LAS unsigned*)(lds + (bufoff) + ldsw + 8192), 16, 0, 0); } while (0)
#define PG8_LDA(dst, b, h) do { _Pragma("unroll") for (int m = 0; m < 4; ++m) _Pragma("unroll") for (int k = 0; k < 2; ++k) dst[m][k] = *(const LAS f16x8*)(lds + PG8_SA(b, h) + aoff + m * 2048 + k * 1024); } while (0)
#define PG8_LDB(dst, b, h) do { _Pragma("unroll") for (int n = 0; n < 2; ++n) _Pragma("unroll") for (int k = 0; k < 2; ++k) dst[n][k] = *(const LAS f16x8*)(lds + PG8_SB(b, h) + boff + n * 2048 + k * 1024); } while (0)
#define PG8_MMA(ai, bj, At, Bt) do { __builtin_amdgcn_s_setprio(1); _Pragma("unroll") for (int m = 0; m < 4; ++m) _Pragma("unroll") for (int n = 0; n < 2; ++n) _Pragma("unroll") for (int k = 0; k < 2; ++k) \
        acc[ai][bj][m][n] = __builtin_amdgcn_mfma_f32_16x16x32_f16(Bt[n][k], At[m][k], acc[ai][bj][m][n], 0, 0, 0); __builtin_amdgcn_s_setprio(0); } while (0)
#define PG8_WAIT_V(n) asm volatile("s_waitcnt vmcnt(" #n ")" ::: "memory")
#define PG8_WAIT_L(n) asm volatile("s_waitcnt lgkmcnt(" #n ")" ::: "memory")
#define PG8_BAR __builtin_amdgcn_s_barrier()
#define PG8_SCHED __builtin_amdgcn_sched_barrier(0)
    Unit cur, nxt; int ui = 0;
    if (!S.next(0, cur)) return;
    E.prepare(lds, S, tid);
    f32x4 acc[2][2][4][2];
#pragma unroll
    for (int a = 0; a < 2; ++a)
#pragma unroll
        for (int b = 0; b < 2; ++b)
#pragma unroll
            for (int m = 0; m < 4; ++m)
#pragma unroll
                for (int n = 0; n < 2; ++n) acc[a][b][m][n] = (f32x4){0.f, 0.f, 0.f, 0.f};
    f16x8 At[4][2], B0[2][2], B1[2][2];
    const char* cB = (const char*)g.Bt + (size_t)cur.pn * tstep;
    PG8_STAGE(PG8_SB(0, 0), cB); PG8_STAGE(PG8_SB(0, 1), cB + hstep); PG8_STAGE_A(PG8_SA(0, 0), cur.pm, 0, 0); PG8_STAGE_A(PG8_SA(0, 1), cur.pm, 0, 1);
    if (wr == 1) PG8_BAR;
    PG8_WAIT_V(2); PG8_BAR;
    PG8_STAGE(PG8_SB(1, 0), cB + kstep); PG8_STAGE_A(PG8_SA(1, 0), cur.pm, 1, 0); PG8_STAGE(PG8_SB(1, 1), cB + hstep + kstep);
    PG8_WAIT_V(6); PG8_BAR;
    for (;;) {
        const bool has_next = S.next(ui + 1, nxt);
        const int npm = has_next ? nxt.pm : cur.pm; const char* nB = has_next ? (const char*)g.Bt + (size_t)nxt.pn * tstep : cB;
        for (int t = 0; t < nt; t += 2) {
            const bool last = (t == nt - 2);
            const int pm2 = last ? npm : cur.pm, kt2 = last ? 0 : t + 2;
            const char* b2 = last ? nB : cB + (size_t)(t + 2) * kstep; const char* b3 = b2 + kstep;
            PG8_LDB(B0, 0, 0); PG8_LDB(B1, 0, 1); PG8_SCHED; PG8_LDA(At, 0, 0); PG8_STAGE_A(PG8_SA(1, 1), cur.pm, t + 1, 1);
            PG8_WAIT_V(8); PG8_WAIT_L(0); PG8_BAR; PG8_MMA(0, 0, At, B0); PG8_MMA(0, 1, At, B1); PG8_BAR; PG8_SCHED;
            PG8_LDA(At, 0, 1); PG8_STAGE(PG8_SB(0, 0), b2); PG8_STAGE(PG8_SB(0, 1), b2 + hstep); PG8_STAGE_A(PG8_SA(0, 0), pm2, kt2, 0);
            PG8_WAIT_V(8); PG8_WAIT_L(0); PG8_BAR; PG8_MMA(1, 0, At, B0); PG8_MMA(1, 1, At, B1); PG8_BAR; PG8_SCHED;
            PG8_LDB(B0, 1, 0); PG8_LDB(B1, 1, 1); PG8_SCHED; PG8_LDA(At, 1, 0); PG8_STAGE_A(PG8_SA(0, 1), pm2, kt2, 1);
            PG8_WAIT_V(8); PG8_WAIT_L(0); PG8_BAR; PG8_MMA(0, 0, At, B0); PG8_MMA(0, 1, At, B1); PG8_BAR; PG8_SCHED;
            PG8_LDA(At, 1, 1); PG8_STAGE(PG8_SB(1, 0), b3); PG8_STAGE(PG8_SB(1, 1), b3 + hstep); PG8_STAGE_A(PG8_SA(1, 0), pm2, kt2 + 1, 0);
            PG8_WAIT_V(8); PG8_WAIT_L(0); PG8_BAR; PG8_MMA(1, 0, At, B0); PG8_MMA(1, 1, At, B1); PG8_BAR; PG8_SCHED;
        }
        if (wr == 0) PG8_BAR;
        E(acc, cur, ui, lds, wr, wc, fr, fq);
        if (!has_next) break;
#pragma unroll
        for (int a = 0; a < 2; ++a)
#pragma unroll
            for (int b = 0; b < 2; ++b)
#pragma unroll
                for (int m = 0; m < 4; ++m)
#pragma unroll
                    for (int n = 0; n < 2; ++n) acc[a][b][m][n] = (f32x4){0.f, 0.f, 0.f, 0.f};
        cur = nxt; cB = nB; ++ui;
        if (wr == 1) PG8_BAR;
    }
    PG8_WAIT_V(0);
    PG8_BAR;
#undef PG8_SA
#undef PG8_SB
#undef PG8_STAGE
#undef PG8_STAGE_A
#undef PG8_LDA
#undef PG8_LDB
#undef PG8_MMA
#undef PG8_WAIT_V
#undef PG8_WAIT_L
#undef PG8_BAR
#undef PG8_SCHED
}
}

__host__ __device__ __forceinline__ int colmap(int rho) { const int bj = rho >> 7, wc = (rho >> 5) & 3, n = (rho >> 4) & 1, fq = (rho >> 2) & 3, j = rho & 3; return 64 * wc + 32 * bj + 8 * fq + 4 * n + j; }

__device__ __forceinline__ float silu_f(float z) { return z * __builtin_amdgcn_rcpf(1.0f + __builtin_amdgcn_exp2f(-LOG2E * z)); }
__device__ __forceinline__ u32x4 pack8(const float* v) {
    f16x8 h;
#pragma unroll
    for (int i = 0; i < 8; ++i) h[i] = (f16)v[i];
    return __builtin_bit_cast(u32x4, h);
}

__device__ __forceinline__ void gemm1_tail_quadrant(LAS unsigned char* lds, const f16* A, const f16* Bt, unsigned char* ws, int pm, int pn, int ai, int bj) {
    using namespace pg8;
    int tid_ = threadIdx.x; asm volatile("" : "+v"(tid_));
    const int tid = tid_, wid = __builtin_amdgcn_readfirstlane(tid >> 6), lane = tid & 63, wr = wid >> 2, wc = wid & 3, fr = lane & 15, fq = lane >> 4;
    constexpr int K = 1024, NT = K / BK;
    unsigned voff[2];
#pragma unroll
    for (int i = 0; i < 2; ++i) { int R, C; stage_rc(tid * 16 + i * 8192, R, C); voff[i] = (unsigned)(R * K + C) * 2u; }
    const char* abase = (const char*)A + ((size_t)pm * 256 + ai * 128) * K * 2;
    const char* bbase = (const char*)Bt + ((size_t)pn * 256 + bj * 128) * K * 2;
    const unsigned ldsw = (unsigned)wid * 1024u;
    const int aoff = lds_byte(wr * 64 + fr, fq * 8), boff = lds_byte(wc * 32 + fr, fq * 8);
#define QSTAGE(s_, kt_) do { _Pragma("unroll") for (int _i = 0; _i < 2; ++_i) { \
        __builtin_amdgcn_global_load_lds((const unsigned*)(abase + (size_t)(kt_) * (BK * 2) + voff[_i]), (LAS unsigned*)(lds + (s_) * 32768 + ldsw + _i * 8192), 16, 0, 0); \
        __builtin_amdgcn_global_load_lds((const unsigned*)(bbase + (size_t)(kt_) * (BK * 2) + voff[_i]), (LAS unsigned*)(lds + (s_) * 32768 + 16384 + ldsw + _i * 8192), 16, 0, 0); } } while (0)
    f32x4 acc[4][2];
#pragma unroll
    for (int m = 0; m < 4; ++m)
#pragma unroll
        for (int n = 0; n < 2; ++n) acc[m][n] = (f32x4){0.f, 0.f, 0.f, 0.f};
    QSTAGE(0, 0); QSTAGE(1, 1); QSTAGE(2, 2);
#pragma unroll 1
    for (int t = 0; t < NT; ++t) {
        if (t <= NT - 3) asm volatile("s_waitcnt vmcnt(8)" ::: "memory"); else if (t == NT - 2) asm volatile("s_waitcnt vmcnt(4)" ::: "memory"); else asm volatile("s_waitcnt vmcnt(0)" ::: "memory");
        __builtin_amdgcn_s_barrier();
        if (t + 3 < NT) QSTAGE((t + 3) & 3, t + 3);
        LAS unsigned char* sl = lds + (t & 3) * 32768;
        f16x8 At[4][2], Bf[2][2];
#pragma unroll
        for (int m = 0; m < 4; ++m)
#pragma unroll
            for (int k = 0; k < 2; ++k) At[m][k] = *(const LAS f16x8*)(sl + aoff + m * 2048 + k * 1024);
#pragma unroll
        for (int n = 0; n < 2; ++n)
#pragma unroll
            for (int k = 0; k < 2; ++k) Bf[n][k] = *(const LAS f16x8*)(sl + 16384 + boff + n * 2048 + k * 1024);
#pragma unroll
        for (int m = 0; m < 4; ++m)
#pragma unroll
            for (int n = 0; n < 2; ++n)
#pragma unroll
                for (int k = 0; k < 2; ++k) acc[m][n] = __builtin_amdgcn_mfma_f32_16x16x32_f16(Bf[n][k], At[m][k], acc[m][n], 0, 0, 0);
    }
#undef QSTAGE
    const float* SS = (const float*)(ws + WS_SS); f16* Z = (f16*)(ws + WS_Z);
    const int row0 = pm * 256 + ai * 128 + wr * 64 + fr;
    f32x4 part[4];
#pragma unroll
    for (int m = 0; m < 4; ++m) part[m] = *(const f32x4*)(SS + (size_t)(row0 + m * 16) * 16 + 4 * fq);
#pragma unroll
    for (int m = 0; m < 4; ++m) {
        float t = (part[m][0] + part[m][1]) + (part[m][2] + part[m][3]);
        t += __shfl_xor(t, 16); t += __shfl_xor(t, 32);
        const float rs = __builtin_amdgcn_rsqf(t * (1.0f / 1024.0f) + EPS);
        const int row = row0 + m * 16;
        float v[8];
#pragma unroll
        for (int e = 0; e < 8; ++e) v[e] = acc[m][e >> 2][e & 3] * rs;
        const int cg8 = 8 * (wc & 1) + 4 * bj + fq;
        f16* p = Z + (((size_t)(((row >> 12) * 4 + (pn - 7)) * 16 + cg8) * 4096 + (row & 4095)) * 2 + (wc >> 1)) * 8;
        *(u32x4*)p = pack8(v);
    }
    asm volatile("s_waitcnt vmcnt(0)" ::: "memory");
    __syncthreads();
}

struct Epi1 {
    unsigned char* __restrict__ ws; const float* __restrict__ qg; const float* __restrict__ kg;
    __device__ __forceinline__ void prepare(LAS unsigned char* lds, const pg8::StaticOrder& S, int tid) const {
        const float* SS = (const float*)(ws + WS_SS);
        f32x4 p0[9], p1[9];
#pragma unroll
        for (int i = 0; i < 9; ++i) {
            pg8::Unit u; p0[i] = (f32x4){0.f, 0.f, 0.f, 0.f}; p1[i] = p0[i];
            if (S.next(i, u)) { const float* sp = SS + (size_t)(u.pm * 256 + (tid >> 1)) * 16 + (tid & 1) * 8; p0[i] = *(const f32x4*)sp; p1[i] = *(const f32x4*)(sp + 4); }
        }
#pragma unroll
        for (int i = 0; i < 9; ++i) {
            float t = ((p0[i][0] + p0[i][1]) + (p0[i][2] + p0[i][3])) + ((p1[i][0] + p1[i][1]) + (p1[i][2] + p1[i][3]));
            t += __shfl_xor(t, 1);
            if ((tid & 1) == 0) ((LAS f16*)(lds + LDS_RS))[i * 256 + (tid >> 1)] = (f16)(1.0f / sqrtf(t * (1.0f / 1024.0f) + EPS));
        }
        __syncthreads();
    }
    __device__ __forceinline__ void operator()(const f32x4 (&acc)[2][2][4][2], const pg8::Unit& u, int ui, LAS unsigned char* lds, int wr, int wc, int fr_, int fq_) const {
        int fr = fr_, fq = fq_; asm volatile("" : "+v"(fr), "+v"(fq));
        const float* ropeC = (const float*)(ws + WS_ROPE); const float* ropeS = ropeC + 4096 * 32; const float* rot = (const float*)(ws + WS_ROT);
        f16* Q = (f16*)(ws + WS_Q); f16* K = (f16*)(ws + WS_K); f16* V = (f16*)(ws + WS_V); f16* GA = (f16*)(ws + WS_GA); f16* GF = (f16*)(ws + WS_GF); f16* Z = (f16*)(ws + WS_Z);
        const int pn = u.pn;
        const bool is_qk = (pn <= 1) || (pn == 2 && wc < 2);
        const int row0 = u.pm * 256 + wr * 64 + fr;
        float rsv[8];
#pragma unroll
        for (int i = 0; i < 8; ++i) rsv[i] = (float)((const LAS f16*)(lds + LDS_RS))[ui * 256 + wr * 64 + fr + (i >> 2) * 128 + (i & 3) * 16];
        if (is_qk) {
            const float* gain = (pn <= 1) ? qg : kg;
            const float oscale = (pn <= 1) ? (0.125f * LOG2E) : 1.0f;
            f32x4 gv[2][2];
#pragma unroll
            for (int bj = 0; bj < 2; ++bj)
#pragma unroll
                for (int n = 0; n < 2; ++n) gv[bj][n] = *(const f32x4*)(gain + 32 * bj + 8 * fq + 4 * n);
            const int pos0 = row0 & (SEQ - 1);
            f32x4 cs[2], sn[2], c16[2], s16[2];
#pragma unroll
            for (int n = 0; n < 2; ++n) {
                cs[n] = *(const f32x4*)(ropeC + pos0 * 32 + 8 * fq + 4 * n); sn[n] = *(const f32x4*)(ropeS + pos0 * 32 + 8 * fq + 4 * n);
                c16[n] = *(const f32x4*)(rot + 8 * fq + 4 * n); s16[n] = *(const f32x4*)(rot + 32 + 8 * fq + 4 * n);
            }
#pragma unroll
            for (int ai = 0; ai < 2; ++ai) {
                if (ai == 1) {
#pragma unroll
                    for (int k = 0; k < 5; ++k)
#pragma unroll
                        for (int n = 0; n < 2; ++n) { const f32x4 c2 = cs[n] * c16[n] - sn[n] * s16[n]; sn[n] = sn[n] * c16[n] + cs[n] * s16[n]; cs[n] = c2; }
                }
#pragma unroll
                for (int m = 0; m < 4; ++m) {
                    const int row = row0 + ai * 128 + m * 16;
                    const float rs = rsv[ai * 4 + m];
                    float v[2][8];
#pragma unroll
                    for (int bj = 0; bj < 2; ++bj)
#pragma unroll
                        for (int e = 0; e < 8; ++e) v[bj][e] = acc[ai][bj][m][e >> 2][e & 3] * rs;
                    float ss = 0.f;
#pragma unroll
                    for (int bj = 0; bj < 2; ++bj)
#pragma unroll
                        for (int e = 0; e < 8; ++e) ss += v[bj][e] * v[bj][e];
                    ss += __shfl_xor(ss, 16); ss += __shfl_xor(ss, 32);
                    const float rn = __builtin_amdgcn_rsqf(ss * (1.0f / 64.0f) + EPS);
                    float o0[8], o1[8];
#pragma unroll
                    for (int e = 0; e < 8; ++e) {
                        const float cc = cs[e >> 2][e & 3], sv = sn[e >> 2][e & 3];
                        const float q0 = v[0][e] * rn * gv[0][e >> 2][e & 3], q1 = v[1][e] * rn * gv[1][e >> 2][e & 3];
                        o0[e] = (q0 * cc - q1 * sv) * oscale; o1[e] = (q1 * cc + q0 * sv) * oscale;
                    }
                    f16* p = (pn <= 1) ? Q + (size_t)row * 512 + (pn * 4 + wc) * 64 + 8 * fq : K + (size_t)row * 128 + wc * 64 + 8 * fq;
                    *(u32x4*)p = pack8(o0); *(u32x4*)(p + 32) = pack8(o1);
                    if (m < 3) {
#pragma unroll
                        for (int n = 0; n < 2; ++n) { const f32x4 c2 = cs[n] * c16[n] - sn[n] * s16[n]; sn[n] = sn[n] * c16[n] + cs[n] * s16[n]; cs[n] = c2; }
                    }
                }
            }
        } else {
#pragma unroll
            for (int ai = 0; ai < 2; ++ai)
#pragma unroll
                for (int m = 0; m < 4; ++m) {
                    const int row = row0 + ai * 128 + m * 16;
                    const float rs = rsv[ai * 4 + m];
                    float v[2][8];
#pragma unroll
                    for (int bj = 0; bj < 2; ++bj)
#pragma unroll
                        for (int e = 0; e < 8; ++e) v[bj][e] = acc[ai][bj][m][e >> 2][e & 3] * rs;
                    if (pn == 2) {
                        f16* p = V + (size_t)row * 128 + (wc - 2) * 64 + 8 * fq; *(u32x4*)p = pack8(v[0]); *(u32x4*)(p + 32) = pack8(v[1]);
                    } else if (pn <= 4) {
#pragma unroll
                        for (int bj = 0; bj < 2; ++bj)
#pragma unroll
                            for (int e = 0; e < 8; ++e) v[bj][e] = silu_f(v[bj][e]);
                        f16* p = GA + (size_t)row * 512 + (pn - 3) * 256 + wc * 64 + 8 * fq;
                        *(u32x4*)p = pack8(v[0]); *(u32x4*)(p + 32) = pack8(v[1]);
                    } else if (pn <= 6) {
#pragma unroll
                        for (int bj = 0; bj < 2; ++bj)
#pragma unroll
                            for (int e = 0; e < 8; ++e) v[bj][e] = silu_f(v[bj][e]);
                        const int gq = 2 * (pn - 5) + (wc >> 1), cg8 = 8 * (wc & 1) + fq;
                        f16* p = GF + ((size_t)(((row >> 12) * 4 + gq) * 16 + cg8) * 4096 + (row & 4095)) * 8;
                        *(u32x4*)p = pack8(v[0]); *(u32x4*)(p + (size_t)4 * 4096 * 8) = pack8(v[1]);
                    } else {
                        const int cg8 = 8 * (wc & 1) + fq;
                        f16* p = Z + (((size_t)(((row >> 12) * 4 + (pn - 7)) * 16 + cg8) * 4096 + (row & 4095)) * 2 + (wc >> 1)) * 8;
                        *(u32x4*)p = pack8(v[0]); *(u32x4*)(p + (size_t)4 * 4096 * 16) = pack8(v[1]);
                    }
                }
        }
    }
};

struct Epi2 {
    const float* __restrict__ xp; const float* __restrict__ xs; float* __restrict__ out; f16* XH; float* __restrict__ SS; int layer;
    __device__ __forceinline__ void prepare(LAS unsigned char*, const pg8::StaticOrder&, int) const {}
    __device__ __forceinline__ void operator()(const f32x4 (&acc)[2][2][4][2], const pg8::Unit& u, int, LAS unsigned char*, int wr, int wc, int fr_, int fq_) const {
        int fr = fr_, fq = fq_; asm volatile("" : "+v"(fr), "+v"(fq));
        const int row0 = u.pm * 256 + wr * 64 + fr, col0 = u.pn * 256 + wc * 64 + 8 * fq;
        if (layer == 0) {
#pragma unroll
            for (int ai = 0; ai < 2; ++ai) {
                f16x8 xh[4][2];
#pragma unroll
                for (int m = 0; m < 4; ++m)
#pragma unroll
                    for (int bj = 0; bj < 2; ++bj) xh[m][bj] = *(const f16x8*)(XH + (size_t)(row0 + ai * 128 + m * 16) * DM + col0 + bj * 32);
#pragma unroll
                for (int m = 0; m < 4; ++m) {
                    const int row = row0 + ai * 128 + m * 16;
                    float ss = 0.f;
#pragma unroll
                    for (int bj = 0; bj < 2; ++bj) {
                        f16x8 hv;
#pragma unroll
                        for (int e = 0; e < 8; ++e) { hv[e] = (f16)((float)xh[m][bj][e] + acc[ai][bj][m][e >> 2][e & 3]); const float tr = (float)hv[e]; ss += tr * tr; }
                        *(f16x8*)(XH + (size_t)row * DM + col0 + bj * 32) = hv;
                    }
                    ss += __shfl_xor(ss, 16); ss += __shfl_xor(ss, 32);
                    if (fq == 0) SS[(size_t)row * 16 + u.pn * 4 + wc] = ss;
                }
            }
        } else {
            f16x8 xh[2][4][2];
#pragma unroll
            for (int ai = 0; ai < 2; ++ai)
#pragma unroll
                for (int m = 0; m < 4; ++m)
#pragma unroll
                    for (int bj = 0; bj < 2; ++bj) xh[ai][m][bj] = *(const f16x8*)(XH + (size_t)(row0 + ai * 128 + m * 16) * DM + col0 + bj * 32);
#pragma unroll
            for (int ai = 0; ai < 2; ++ai)
#pragma unroll
                for (int m = 0; m < 4; ++m) {
                    float* dst = out + (size_t)(row0 + ai * 128 + m * 16) * DM + col0;
#pragma unroll
                    for (int bj = 0; bj < 2; ++bj) {
                        f32x4 x0, x1;
#pragma unroll
                        for (int e = 0; e < 4; ++e) { x0[e] = (float)xh[ai][m][bj][e] + acc[ai][bj][m][0][e]; x1[e] = (float)xh[ai][m][bj][4 + e] + acc[ai][bj][m][1][e]; }
                        *(f32x4*)(dst + bj * 32) = x0; *(f32x4*)(dst + bj * 32 + 4) = x1;
                    }
                }
        }
    }
};

__device__ void p0_mmat(const Args& a, LAS unsigned char* lds) {
    LAS float* ct = (LAS float*)lds; LAS float* st = ct + 128;
    int tid_ = threadIdx.x; asm volatile("" : "+v"(tid_)); const int tid = tid_;
    if (tid < 128) { float s, c; sincospif((float)tid * (1.0f / 64.0f), &s, &c); ct[tid] = c; st[tid] = s; }
    __syncthreads();
    float* MM = (float*)(a.ws + WS_MM);
    const int total = 2 * 4 * 128 * 64;
    for (int idx = blockIdx.x * NTHREADS + tid; idx < total; idx += gridDim.x * NTHREADS) {
        const int d4 = idx & 63, cp = (idx >> 6) & 127, lg = idx >> 13;
        const float* W = a.w_four + (size_t)lg * 128 * 128 + 4 * (d4 & 31);
        const LAS float* tb = (d4 < 32) ? ct : st;
        f32x4 acc = {0.f, 0.f, 0.f, 0.f};
#pragma unroll 8
        for (int c = 0; c < 128; ++c) acc += *(const f32x4*)(W + c * 128) * tb[(cp * c) & 127];
        *(f32x4*)(MM + ((size_t)(lg * 128 + cp) * 256 + 4 * d4)) = acc * 0.08838834764831845f;
    }
    __syncthreads();
}
__device__ void p0_rope(const Args& a) {
    float* rc = (float*)(a.ws + WS_ROPE); float* rsn = rc + 4096 * 32;
    for (int idx = blockIdx.x * NTHREADS + threadIdx.x; idx < 4096 * 32; idx += gridDim.x * NTHREADS) {
        const int i = idx & 31, pos = idx >> 5;
        const float inv_freq = 1.0f / powf(10000.0f, (float)i * (1.0f / 32.0f));
        const float ang = (float)pos * inv_freq;
        float s, c; sincosf(ang, &s, &c);
        rc[idx] = c; rsn[idx] = s;
    }
    if (blockIdx.x == 0 && threadIdx.x < 64) {
        float* rot = (float*)(a.ws + WS_ROT);
        const int i = threadIdx.x & 31, step = (threadIdx.x < 32) ? 16 : 128;
        const float inv_freq = 1.0f / powf(10000.0f, (float)i * (1.0f / 32.0f));
        float s, c; sincosf((float)step * inv_freq, &s, &c);
        rot[(threadIdx.x < 32 ? 0 : 64) + i] = c; rot[(threadIdx.x < 32 ? 32 : 96) + i] = s;
    }
}
__device__ void p0_xconv(const Args& a) {
    f16* XH = (f16*)(a.ws + WS_XH); float* SS = (float*)(a.ws + WS_SS);
    int tid_ = threadIdx.x; asm volatile("" : "+v"(tid_));
    const int lane = tid_ & 63, wv = tid_ >> 6;
    const int nwv = (int)gridDim.x * 8;
    for (int row0 = (int)blockIdx.x * 8 + wv; row0 < MROWS; row0 += 4 * nwv) {
        f32x4 v[4][4];
#pragma unroll
        for (int r = 0; r < 4; ++r) {
            const int row = row0 + r * nwv;
            if (row < MROWS) {
                const float* src = (row < ROWS_PROMPT) ? a.x_prompt + (size_t)row * DM : a.x_sample + (size_t)(row - ROWS_PROMPT) * DM;
#pragma unroll
                for (int i = 0; i < 4; ++i) v[r][i] = __builtin_nontemporal_load((const f32x4*)(src + i * 256 + lane * 4));
            }
        }
#pragma unroll
        for (int r = 0; r < 4; ++r) {
            const int row = row0 + r * nwv;
            if (row < MROWS) {
                float ss = 0.f;
#pragma unroll
                for (int i = 0; i < 4; ++i) {
                    const f32x4 x = v[r][i];
                    ss += (x[0] * x[0] + x[1] * x[1]) + (x[2] * x[2] + x[3] * x[3]);
                    f16x4 h; h[0] = (f16)x[0]; h[1] = (f16)x[1]; h[2] = (f16)x[2]; h[3] = (f16)x[3];
                    *(f16x4*)(XH + (size_t)row * DM + i * 256 + lane * 4) = h;
                }
#pragma unroll
                for (int o = 1; o < 64; o <<= 1) ss += __shfl_xor(ss, o);
                if (lane < 16) SS[(size_t)row * 16 + lane] = (lane == 0) ? ss : 0.f;
            }
        }
    }
}
__device__ void p_weights_plain(const Args& a) {
    int tid_ = threadIdx.x; asm volatile("" : "+v"(tid_)); const int tid = tid_;
    const int cq = tid & 63, rq = tid >> 6;
    const int lc0 = 4 * cq;
    const int rho0 = 128 * ((lc0 >> 5) & 1) + 32 * (lc0 >> 6) + 16 * ((lc0 >> 2) & 1) + 4 * ((lc0 >> 3) & 3);
    f16* W1T = (f16*)(a.ws + WS_W1T); f16* W2T = (f16*)(a.ws + WS_W2T);
    for (int u = blockIdx.x; u < 704; u += gridDim.x) {
        const float* w; f16* dst; int ldw, col; f32x4 gn = {1.f, 1.f, 1.f, 1.f};
        if (u < 448) {
            const int l = u / 224, r = u % 224, pn = r >> 5, kblk = r & 31, k0 = kblk * 32 + 4 * rq;
            const int L = pn * 256 + lc0; col = (L < 1280) ? L : L + 512; ldw = INW;
            w = a.w_in + (size_t)l * DM * INW + (size_t)k0 * INW;
            gn = *(const f32x4*)(a.norm_gain + l * DM + k0);
            dst = W1T + ((size_t)l * N1 + pn * 256 + rho0) * 1024 + k0;
        } else {
            const int r = u - 448, l = r >> 7, pn = (r >> 5) & 3, kblk = r & 31, k0 = kblk * 32 + 4 * rq;
            col = pn * 256 + lc0; ldw = DM;
            w = a.w_out + (size_t)l * DM * DM + (size_t)k0 * DM;
            dst = W2T + ((size_t)l * DM + pn * 256 + rho0) * 1024 + k0;
        }
        f32x4 x[4];
#pragma unroll
        for (int i = 0; i < 4; ++i) x[i] = *(const f32x4*)(w + (size_t)i * ldw + col) * gn[i];
#pragma unroll
        for (int j = 0; j < 4; ++j) {
            f16x4 o;
#pragma unroll
            for (int i = 0; i < 4; ++i) o[i] = (f16)x[i][j];
            *(f16x4*)(dst + (size_t)j * 1024) = o;
        }
    }
}
__device__ void p_weights_prod(const Args& a, LAS unsigned char* lds) {
    int tid_ = threadIdx.x; asm volatile("" : "+v"(tid_)); const int tid = tid_;
    const int cq = tid & 63, rq = tid >> 6;
    const int lc0 = 4 * cq;
    const int rho0 = 128 * ((lc0 >> 5) & 1) + 32 * (lc0 >> 6) + 16 * ((lc0 >> 2) & 1) + 4 * ((lc0 >> 3) & 3);
    f16* W1T = (f16*)(a.ws + WS_W1T); const float* MM = (const float*)(a.ws + WS_MM);
    LAS float* wt = (LAS float*)lds;
    LAS float* mmt = (LAS float*)(lds + 16384);
    for (int u = blockIdx.x; u < 256; u += gridDim.x) {
        const int l = u >> 7, g = (u >> 5) & 3, kblk = u & 31, pn = 7 + g;
        __syncthreads();
        {
            const int rr = tid >> 4, c8 = (tid & 15) * 8;
            const float* src = a.w_in + (size_t)l * DM * INW + (size_t)(kblk * 32 + rr) * INW + 1280 + g * 128 + c8;
            const f32x4* msrc = (const f32x4*)(MM + (size_t)(l * 4 + g) * 128 * 256) + tid;
            f32x4 mreg[16];
#pragma unroll
            for (int j = 0; j < 16; ++j) mreg[j] = msrc[j * NTHREADS];
            *(LAS f32x4*)(wt + rr * 128 + c8) = *(const f32x4*)src; *(LAS f32x4*)(wt + rr * 128 + c8 + 4) = *(const f32x4*)(src + 4);
#pragma unroll
            for (int j = 0; j < 16; ++j) ((LAS f32x4*)mmt)[tid + j * NTHREADS] = mreg[j];
        }
        __syncthreads();
        f32x4 acc[4];
#pragma unroll
        for (int r2 = 0; r2 < 4; ++r2) acc[r2] = (f32x4){0.f, 0.f, 0.f, 0.f};
#pragma unroll 2
        for (int c0 = 0; c0 < 128; c0 += 4) {
            f32x4 w4[4], m4[4];
#pragma unroll
            for (int r2 = 0; r2 < 4; ++r2) w4[r2] = *(const LAS f32x4*)(wt + (4 * rq + r2) * 128 + c0);
#pragma unroll
            for (int cc = 0; cc < 4; ++cc) m4[cc] = *(const LAS f32x4*)(mmt + (c0 + cc) * 256 + lc0);
#pragma unroll
            for (int r2 = 0; r2 < 4; ++r2)
#pragma unroll
                for (int cc = 0; cc < 4; ++cc) acc[r2] += m4[cc] * w4[r2][cc];
        }
        const int k0 = kblk * 32 + 4 * rq;
        const f32x4 gn = *(const f32x4*)(a.norm_gain + l * DM + k0);
#pragma unroll
        for (int j = 0; j < 4; ++j) {
            f16x4 o;
#pragma unroll
            for (int r2 = 0; r2 < 4; ++r2) o[r2] = (f16)(acc[r2][j] * gn[r2]);
            *(f16x4*)(W1T + ((size_t)l * N1 + pn * 256 + rho0 + j) * 1024 + k0) = o;
        }
    }
    __syncthreads();
}

typedef float f32x16 __attribute__((ext_vector_type(16)));
typedef short s16x4 __attribute__((ext_vector_type(4)));
__device__ __forceinline__ f16x8 tr_pair(LAS unsigned char* p0, LAS unsigned char* p1) {
    const s16x4 lo = __builtin_amdgcn_ds_read_tr16_b64_v4i16((LAS s16x4*)p0);
    const s16x4 hi = __builtin_amdgcn_ds_read_tr16_b64_v4i16((LAS s16x4*)p1);
    return __builtin_bit_cast(f16x8, __builtin_shufflevector(lo, hi, 0, 1, 2, 3, 4, 5, 6, 7));
}
__device__ __forceinline__ float max3f(float a, float b, float c) { float d; asm("v_max3_f32 %0, %1, %2, %3" : "=v"(d) : "v"(a), "v"(b), "v"(c)); return d; }
__device__ __forceinline__ f16x8 pack_p(const f32x16& p, int s) {
    f16x8 r;
#pragma unroll
    for (int j = 0; j < 8; ++j) r[j] = (f16)p[8 * s + j];
    return r;
}
constexpr int GATE_STEP = 5;
__device__ void attn_phase(const Args& a, LAS unsigned char* lds, int layer) {
    int tid_ = threadIdx.x; asm volatile("" : "+v"(tid_)); const int tid = tid_;
    const int lane = tid & 63, wid = __builtin_amdgcn_readfirstlane(tid >> 6), r = lane & 31, h = lane >> 5;
    const int hq = wid >> 1, qh = wid & 1;
    const f16* Q = (const f16*)(a.ws + WS_Q); const f16* K = (const f16*)(a.ws + WS_K); const f16* V = (const f16*)(a.ws + WS_V);
    const f16* GA = (const f16*)(a.ws + WS_GA); f16* MIX = (f16*)(a.ws + WS_MIX);
    const int G = gridDim.x;
    int unit = blockIdx.x;
    if (unit >= 1536) return;
    float m0;
    {
        float gq = fabsf(a.qgain[layer * 64 + lane]), gk = fabsf(a.kgain[layer * 64 + lane]);
#pragma unroll
        for (int o = 1; o < 64; o <<= 1) { gq = fmaxf(gq, __shfl_xor(gq, o)); gk = fmaxf(gk, __shfl_xor(gk, o)); }
        m0 = __builtin_bit_cast(float, __builtin_amdgcn_readfirstlane(__builtin_bit_cast(int, 8.0f * gq * gk * LOG2E - 8.0f)));
    }
    u32x4 kreg[5], vreg[5];
#define ATT_LOAD(un) do { const int _qb = (un) & 63, _kvh = ((un) >> 6) & 1, _b = (un) >> 7, _q0 = _qb * 64; \
        _Pragma("unroll") for (int j = 0; j < 5; ++j) { const int i = tid + NTHREADS * j, rr = i >> 3, c = i & 7, kp0 = _q0 - 128 + rr, kp = kp0 < 0 ? 0 : (kp0 > SEQ - 1 ? SEQ - 1 : kp0); \
            const size_t off = ((size_t)(_b * SEQ + kp)) * 128 + _kvh * 64 + c * 8; kreg[j] = *(const u32x4*)(K + off); vreg[j] = *(const u32x4*)(V + off); } \
        } while (0)
    ATT_LOAD(unit);
    f16x8 qf[4];
#define ATT_QLOAD(un) do { const int _qp = ((un) & 63) * 64 + 32 * qh + r, _head = (((un) >> 6) & 1) * 4 + hq; const size_t _grow = (size_t)(((un) >> 7) * SEQ + _qp); \
        _Pragma("unroll") for (int s = 0; s < 4; ++s) qf[s] = *(const f16x8*)(Q + _grow * 512 + _head * 64 + 16 * s + 8 * h); } while (0)
    ATT_QLOAD(unit);
    const int blk = (lane >> 4) & 1, tq = (lane & 15) >> 2, tp = lane & 3;
#pragma unroll 1
    for (; unit < 1536; unit += G) {
        const int qb = unit & 63, kvh = (unit >> 6) & 1, b = unit >> 7, q0 = qb * 64;
        const int head = kvh * 4 + hq, qp = q0 + 32 * qh + r;
        const size_t grow = (size_t)(b * SEQ + qp);
        const float sinkv = a.sink[layer * 8 + head];
        __syncthreads();
#pragma unroll
        for (int j = 0; j < 5; ++j) {
            const int i = tid + NTHREADS * j, rr = i >> 3, c = i & 7;
            *(LAS u32x4*)(lds + rr * 128 + ((c ^ ((rr >> 1) & 7)) << 4)) = kreg[j];
            *(LAS u32x4*)(lds + 40960 + rr * 128 + (((c >> 1) ^ (rr & 3)) << 5) + ((c & 1) << 4)) = vreg[j];
        }
        __syncthreads();
        { const int un = (unit + G < 1536) ? unit + G : unit; ATT_LOAD(un); }
        f32x16 O0, O1;
#pragma unroll
        for (int i = 0; i < 16; ++i) { O0[i] = 0.f; O1[i] = 0.f; }
        float l = h ? 0.0f : __builtin_amdgcn_exp2f(sinkv * LOG2E - m0);
        const int lo_d = (-qp > -128) ? -qp : -128, hi_d = (SEQ - 1 - qp < 128) ? (SEQ - 1 - qp) : 128;
        const int ksw = (r >> 1) & 7;
        LAS unsigned char* kbase = lds + r * 128 + qh * 4096;
        LAS unsigned char* vbase = lds + 40960 + (4 * h + tq) * 128 + tp * 8 + qh * 4096;
        const int vsw0 = ((0 + blk) ^ tq) << 5, vsw1 = ((2 + blk) ^ tq) << 5;
        const int dbase = q0 - 128 + 32 * qh + 4 * h - qp;
        f16x8 kf[4];
#define ATT_KREAD(j_) do { _Pragma("unroll") for (int s = 0; s < 4; ++s) kf[s] = *(const LAS f16x8*)(kbase + (j_) * 4096 + (((2 * s + h) ^ ksw) << 4)); } while (0)
        f32x16 A;
#pragma unroll
        for (int i = 0; i < 16; ++i) A[i] = -m0;
        ATT_KREAD(0);
#pragma unroll
        for (int s = 0; s < 4; ++s) A = __builtin_amdgcn_mfma_f32_32x32x16_f16(kf[s], qf[s], A, 0, 0, 0);
        u32x4 gw[2][2];
        auto step = [&](const int j, auto mode_) __attribute__((always_inline)) {
            constexpr int MODE = decltype(mode_)::value;
            f32x16 S = A;
            if (MODE < 2) ATT_KREAD(j + 1);
            f16x8 vf[2][2];
#pragma unroll
            for (int sp = 0; sp < 2; ++sp) {
                LAS unsigned char* va = vbase + (32 * j + 16 * sp) * 128;
                vf[sp][0] = tr_pair(va + vsw0, va + 1024 + vsw0);
                vf[sp][1] = tr_pair(va + vsw1, va + 1024 + vsw1);
            }
            __builtin_amdgcn_sched_barrier(0);
            if (MODE < 2) {
#pragma unroll
                for (int i = 0; i < 16; ++i) A[i] = -m0;
#pragma unroll
                for (int s = 0; s < 4; ++s) A = __builtin_amdgcn_mfma_f32_32x32x16_f16(kf[s], qf[s], A, 0, 0, 0);
            }
            if (MODE == 0 && j == GATE_STEP) {
#pragma unroll
                for (int dt = 0; dt < 2; ++dt)
#pragma unroll
                    for (int kk = 0; kk < 2; ++kk) gw[dt][kk] = *(const u32x4*)(GA + grow * 512 + head * 64 + 32 * dt + 8 * (2 * kk + h));
            }
            if (MODE == 1) { const int un = (unit + G < 1536) ? unit + G : unit; ATT_QLOAD(un); }
            __builtin_amdgcn_sched_barrier(0);
            const int k0s = q0 - 128 + 32 * (qh + j);
            if (j == 0 || j == 8 || k0s < 0 || k0s + 32 > SEQ) {
                const int base = dbase + 32 * j;
#pragma unroll
                for (int i = 0; i < 16; ++i) { const int d0 = base + (i & 3) + 8 * (i >> 2); if (d0 < lo_d || d0 > hi_d) S[i] = -1e30f; }
            }

#pragma unroll
            for (int i = 0; i < 16; ++i) S[i] = __builtin_amdgcn_exp2f(S[i]);
            l += ((S[0] + S[1]) + (S[2] + S[3])) + ((S[4] + S[5]) + (S[6] + S[7])) + (((S[8] + S[9]) + (S[10] + S[11])) + ((S[12] + S[13]) + (S[14] + S[15])));
#pragma unroll
            for (int sp = 0; sp < 2; ++sp) {
                const f16x8 pf = pack_p(S, sp);
                O0 = __builtin_amdgcn_mfma_f32_32x32x16_f16(vf[sp][0], pf, O0, 0, 0, 0);
                O1 = __builtin_amdgcn_mfma_f32_32x32x16_f16(vf[sp][1], pf, O1, 0, 0, 0);
            }
        };
#pragma unroll 1
        for (int j = 0; j < 7; ++j) step(j, std::integral_constant<int, 0>{});
        step(7, std::integral_constant<int, 1>{});
        step(8, std::integral_constant<int, 2>{});
#undef ATT_KREAD
        const float inv = 1.0f / (l + __shfl_xor(l, 32));
#pragma unroll
        for (int dt = 0; dt < 2; ++dt)
#pragma unroll
            for (int kk = 0; kk < 2; ++kk) {
                u32x2 glo = {gw[dt][kk][0], gw[dt][kk][1]}, ghi = {gw[dt][kk][2], gw[dt][kk][3]};
#pragma unroll
                for (int w2 = 0; w2 < 2; ++w2) { const auto sw = __builtin_amdgcn_permlane32_swap(glo[w2], ghi[w2], false, false); glo[w2] = sw[0]; ghi[w2] = sw[1]; }
                const f16x4 g0 = __builtin_bit_cast(f16x4, glo), g1 = __builtin_bit_cast(f16x4, ghi);
                f16x4 o0, o1;
#pragma unroll
                for (int j = 0; j < 4; ++j) {
                    o0[j] = (f16)((dt ? O1[8 * kk + j] : O0[8 * kk + j]) * inv * (float)g0[j]);
                    o1[j] = (f16)((dt ? O1[8 * kk + 4 + j] : O0[8 * kk + 4 + j]) * inv * (float)g1[j]);
                }
                u32x2 a0 = __builtin_bit_cast(u32x2, o0), a1 = __builtin_bit_cast(u32x2, o1);
#pragma unroll
                for (int w2 = 0; w2 < 2; ++w2) { const auto sw = __builtin_amdgcn_permlane32_swap(a0[w2], a1[w2], false, false); a0[w2] = sw[0]; a1[w2] = sw[1]; }
                const u32x4 st = {a0[0], a0[1], a1[0], a1[1]};
                *(u32x4*)(MIX + grow * 1024 + head * 64 + 32 * dt + 8 * (2 * kk + h)) = st;
            }
    }
#undef ATT_LOAD
#undef ATT_QLOAD
}

__device__ void fft_tables(LAS unsigned char* lds) {
    LAS f16* CF = (LAS f16*)(lds + LDS_TAB); LAS f16* SF = CF + 4096; LAS f16* NSF = SF + 4096;
    for (int e = threadIdx.x; e < 4096; e += NTHREADS) {
        const int jj = e & 7, lane = (e >> 3) & 63, kt = (e >> 9) & 1, s = e >> 10, h = lane >> 5;
        const int n = 16 * s + 8 * (jj >> 2) + 4 * h + (jj & 3), k = 32 * kt + (lane & 31);
        float sn, cs; sincospif((float)((n * k) & 63) * (1.0f / 32.0f), &sn, &cs);
        CF[e] = (f16)(cs * 0.125f); SF[e] = (f16)(sn * 0.125f); NSF[e] = (f16)(-sn * 0.125f);
    }
}
__device__ void p0_twiddle(const Args& a) {
    f32x2* TW = (f32x2*)(a.ws + WS_TW);
    for (int idx = blockIdx.x * NTHREADS + threadIdx.x; idx < 4096; idx += gridDim.x * NTHREADS) {
        const int lane = idx & 63, reg = (idx >> 6) & 15, kt = (idx >> 10) & 1, mt = idx >> 11, h = lane >> 5;
        const int n2 = 32 * mt + (reg & 3) + 8 * (reg >> 2) + 4 * h, k1 = 32 * kt + (lane & 31);
        float sn, cs; sincospif((float)(n2 * k1) * (1.0f / 2048.0f), &sn, &cs);
        TW[((((mt * 2 + kt) * 8 + (reg >> 1)) * 64 + lane) << 1) + (reg & 1)] = (f32x2){cs, sn};
    }
}
__device__ void fft_phase(const Args& a, LAS unsigned char* lds) {
    int tid_ = threadIdx.x; asm volatile("" : "+v"(tid_)); const int tid = tid_;
    const int lane = tid & 63, wid = __builtin_amdgcn_readfirstlane(tid >> 6), r = lane & 31, h = lane >> 5;
    const f16* Z = (const f16*)(a.ws + WS_Z); const f16* GF = (const f16*)(a.ws + WS_GF);
    const f32x2* TW = (const f32x2*)(a.ws + WS_TW);
    f16* FOUR = (f16*)(a.ws + WS_FOUR);
    const int G = gridDim.x;
    int unit = blockIdx.x;
    if (unit >= 768) return;
    f16x8 pin[4][4];
#define FFT_LOAD(un) do { const size_t _b0 = (size_t)(((un) >> 6) * 4 + (((un) >> 4) & 3)) * 16 + ((un) & 15); \
        int _tl = tid; asm volatile("" : "+v"(_tl)); \
        _Pragma("unroll") for (int it = 0; it < 4; ++it) { const f16* zp = Z + (_b0 * 4096 + 2 * (_tl + NTHREADS * it)) * 16; \
            _Pragma("unroll") for (int q = 0; q < 4; ++q) pin[it][q] = *(const f16x8*)(zp + 8 * q); } } while (0)
    FFT_LOAD(unit);
#pragma unroll 1
    for (; unit < 768; unit += G) {
    const int cg8 = unit & 15, g = (unit >> 4) & 3, b = unit >> 6;
    const size_t blk0 = (size_t)((b * 4 + g) * 16 + cg8) * 4096;
    __syncthreads();
#pragma unroll
    for (int it = 0; it < 4; ++it) {
        const int token = 2 * (tid + NTHREADS * it);
        const int n1 = token >> 6, n2 = token & 63;
        const int off = n1 * 128 + (((n2 >> 4) ^ (n1 & 3)) << 5) + (n2 & 15) * 2;
#pragma unroll
        for (int ch = 0; ch < 8; ++ch) {
            *(LAS f16x2*)(lds + ch * 16384 + off) = (f16x2){pin[it][0][ch], pin[it][2][ch]};
            *(LAS f16x2*)(lds + ch * 16384 + 8192 + off) = (f16x2){pin[it][1][ch], pin[it][3][ch]};
        }
    }
    __syncthreads();
    LAS unsigned char* img = lds + wid * 16384;
    const LAS f16x8* CF = (const LAS f16x8*)(lds + LDS_TAB) + lane; const LAS f16x8* SF = CF + 512; const LAS f16x8* NSF = SF + 512;
    const int blk = (lane >> 4) & 1, tq = (lane & 15) >> 2, tp = lane & 3;
    f32x16 X[2][2];
#pragma unroll
    for (int i = 0; i < 2; ++i)
#pragma unroll
        for (int j = 0; j < 2; ++j)
#pragma unroll
            for (int e = 0; e < 16; ++e) X[i][j][e] = 0.f;
#pragma unroll
    for (int mt = 0; mt < 2; ++mt) {
        f32x16 Yr[2], Yi[2];
#pragma unroll
        for (int j = 0; j < 2; ++j)
#pragma unroll
            for (int e = 0; e < 16; ++e) { Yr[j][e] = 0.f; Yi[j][e] = 0.f; }
#pragma unroll
        for (int which = 0; which < 2; ++which)
#pragma unroll
            for (int s = 0; s < 4; ++s) {
                LAS unsigned char* pa = img + which * 8192 + (16 * s + 4 * h + tq) * 128 + (((2 * mt + blk) ^ tq) << 5) + tp * 8;
                const f16x8 af = tr_pair(pa, pa + 8 * 128);
#pragma unroll
                for (int kt = 0; kt < 2; ++kt) {
                    const f16x8 cf = CF[(s * 2 + kt) * 64], sf = which ? NSF[(s * 2 + kt) * 64] : SF[(s * 2 + kt) * 64];
                    if (which == 0) { Yr[kt] = __builtin_amdgcn_mfma_f32_32x32x16_f16(af, cf, Yr[kt], 0, 0, 0); Yi[kt] = __builtin_amdgcn_mfma_f32_32x32x16_f16(af, sf, Yi[kt], 0, 0, 0); }
                    else { Yr[kt] = __builtin_amdgcn_mfma_f32_32x32x16_f16(af, sf, Yr[kt], 0, 0, 0); Yi[kt] = __builtin_amdgcn_mfma_f32_32x32x16_f16(af, cf, Yi[kt], 0, 0, 0); }
                }
            }
        f16x8 trf[2][2], tif[2][2];
#pragma unroll
        for (int kt = 0; kt < 2; ++kt) {
            int lane_l = lane; asm volatile("" : "+v"(lane_l));
            const f32x4* tw = (const f32x4*)TW + ((mt * 2 + kt) * 8) * 64 + lane_l;
            f32x16 tr, ti;
#pragma unroll
            for (int p = 0; p < 8; ++p) { const f32x4 cs = tw[p * 64];
                tr[2 * p] = Yr[kt][2 * p] * cs[0] - Yi[kt][2 * p] * cs[1]; ti[2 * p] = Yr[kt][2 * p] * cs[1] + Yi[kt][2 * p] * cs[0];
                tr[2 * p + 1] = Yr[kt][2 * p + 1] * cs[2] - Yi[kt][2 * p + 1] * cs[3]; ti[2 * p + 1] = Yr[kt][2 * p + 1] * cs[3] + Yi[kt][2 * p + 1] * cs[2]; }
#pragma unroll
            for (int sp = 0; sp < 2; ++sp) { trf[kt][sp] = pack_p(tr, sp); tif[kt][sp] = pack_p(ti, sp); }
        }
#pragma unroll
        for (int sp = 0; sp < 2; ++sp)
#pragma unroll
            for (int mt2 = 0; mt2 < 2; ++mt2) {
                const f16x8 cf = CF[((2 * mt + sp) * 2 + mt2) * 64], nsf = NSF[((2 * mt + sp) * 2 + mt2) * 64];
#pragma unroll
                for (int kt = 0; kt < 2; ++kt) {
                    X[mt2][kt] = __builtin_amdgcn_mfma_f32_32x32x16_f16(cf, trf[kt][sp], X[mt2][kt], 0, 0, 0);
                    X[mt2][kt] = __builtin_amdgcn_mfma_f32_32x32x16_f16(nsf, tif[kt][sp], X[mt2][kt], 0, 0, 0);
                }
            }
    }
#pragma unroll
    for (int mt2 = 0; mt2 < 2; ++mt2)
#pragma unroll
        for (int kt = 0; kt < 2; ++kt)
#pragma unroll
            for (int e = 0; e < 16; ++e) {
                const int token = 32 * kt + r + 64 * (32 * mt2 + (e & 3) + 8 * (e >> 2) + 4 * h);
                *(LAS f16*)(img + token * 2) = (f16)X[mt2][kt][e];
            }
    f16x8 gt[4][2];
    int tl = tid; asm volatile("" : "+v"(tl));
#pragma unroll
    for (int it = 0; it < 4; ++it) { const f16* gp = GF + (blk0 + 2 * (tl + NTHREADS * it)) * 8; gt[it][0] = *(const f16x8*)gp; gt[it][1] = *(const f16x8*)(gp + 8); }
    { const int un = (unit + G < 768) ? unit + G : unit; FFT_LOAD(un); }
    __syncthreads();
#pragma unroll
    for (int it = 0; it < 4; ++it) {
        const int token = 2 * (tl + NTHREADS * it);
        f16x8 o0, o1;
#pragma unroll
        for (int ch = 0; ch < 8; ++ch) {
            const f16x2 v = *(const LAS f16x2*)(lds + ch * 16384 + token * 2);
            o0[ch] = (f16)((float)v[0] * (float)gt[it][0][ch]); o1[ch] = (f16)((float)v[1] * (float)gt[it][1][ch]);
        }
        *(f16x8*)(FOUR + (blk0 + token) * 8) = o0; *(f16x8*)(FOUR + (blk0 + token) * 8 + 8) = o1;
    }
    }
#undef FFT_LOAD
}

#define XB_TMO      128
#define XB_XCNT(j)  (256  + 64 * (j))
#define XB_XSUB(j)  (1280 + 64 * (j))
#define XB_XGEN(j)  (2304 + 64 * (j))
#define XB_TOP      3328
#define XB_TOPGEN   3392
#define XCD_BAR_WORDS 3456
#define XB_SPIN_CAP (1u << 18)
__device__ __forceinline__ unsigned xb_ld(unsigned* p)              { return __hip_atomic_load(p, __ATOMIC_RELAXED, __HIP_MEMORY_SCOPE_AGENT); }
__device__ __forceinline__ unsigned xb_add(unsigned* p, unsigned v) { return __hip_atomic_fetch_add(p, v, __ATOMIC_RELAXED, __HIP_MEMORY_SCOPE_AGENT); }
__device__ __forceinline__ unsigned xb_xcc_id() { return (unsigned)__builtin_amdgcn_s_getreg((3 << 11) | 20) & 0xFu; }
#define XB_SPIN(cond, bar) do { unsigned _sp = 0; while (cond) { __builtin_amdgcn_s_sleep(1); \
    if ((++_sp & 255u) == 0u) { if (xb_ld(&(bar)[XB_TMO])) break; if (_sp > XB_SPIN_CAP) { atomicAdd(&(bar)[XB_TMO], 1u); break; } } } } while (0)
struct XcdBarrier { unsigned* bar; unsigned x; volatile LAS unsigned* st; };
__device__ __forceinline__ XcdBarrier xcd_barrier_post(unsigned* bar, volatile LAS unsigned* st) {
    XcdBarrier b; b.bar = bar; b.x = xb_xcc_id(); b.st = st;
    if (threadIdx.x == 0) (void)xb_add(&bar[XB_XCNT(b.x)], 1u);
    return b;
}
__device__ __forceinline__ void xcd_barrier_complete(unsigned* bar, unsigned x, unsigned& nloc, unsigned& nx) {
    const unsigned G = gridDim.x * gridDim.y * gridDim.z;
    unsigned sum, cnt, mine, sp = 0u;
    for (;;) {
        sum = 0u; cnt = 0u; mine = 0u;
#pragma unroll 1
        for (unsigned j = 0; j < 16; ++j) { const unsigned c = xb_ld(&bar[XB_XCNT(j)]); sum += c; cnt += (c > 0u) ? 1u : 0u; mine = (j == x) ? c : mine; }
        if (sum == G) break;
        __builtin_amdgcn_s_sleep(1);
        if ((++sp & 255u) == 0u) { if (xb_ld(&bar[XB_TMO])) break; if (sp > XB_SPIN_CAP) { atomicAdd(&bar[XB_TMO], 1u); break; } }
    }
    nloc = mine > 0u ? mine : 1u; nx = cnt > 0u ? cnt : 1u;
}
__device__ __forceinline__ void xcd_barrier(const XcdBarrier& b) {
    asm volatile("s_waitcnt vmcnt(0)" ::: "memory");
    __syncthreads();
    if (threadIdx.x == 0) {
        unsigned* bar = b.bar; asm volatile("" : "+s"(bar));
        __builtin_amdgcn_s_waitcnt(0);
        unsigned nloc = b.st[0], nx = b.st[1];
        if (nloc == 0u) { xcd_barrier_complete(bar, b.x, nloc, nx); b.st[0] = nloc; b.st[1] = nx; }
        const unsigned old = xb_add(&bar[XB_XSUB(b.x)], 1u);
        const unsigned gen = old / nloc;
        if (old + 1u == (gen + 1u) * nloc) {
            __builtin_amdgcn_fence(__ATOMIC_RELEASE, "agent");
            asm volatile("s_waitcnt vmcnt(0)" ::: "memory");
            const unsigned og = xb_add(&bar[XB_TOP], 1u);
            const unsigned tg = og / nx;
            if (og + 1u == (tg + 1u) * nx) xb_add(&bar[XB_TOPGEN], 1u);
            else XB_SPIN(xb_ld(&bar[XB_TOPGEN]) == tg, bar);
            __builtin_amdgcn_fence(__ATOMIC_ACQUIRE, "agent");
            xb_add(&bar[XB_XGEN(b.x)], 1u);
            asm volatile("s_waitcnt vmcnt(0)" ::: "memory");
        } else {
            XB_SPIN(xb_ld(&bar[XB_XGEN(b.x)]) == gen, bar);
            __builtin_amdgcn_fence(__ATOMIC_ACQUIRE, "agent");
            asm volatile("s_waitcnt vmcnt(0)" ::: "memory");
        }
    }
    __syncthreads();
}

__global__ void __launch_bounds__(NTHREADS, 2) hymba_fwd(Args a) {
    extern __shared__ __attribute__((aligned(16))) unsigned char lds_raw[];
    LAS unsigned char* lds = (LAS unsigned char*)lds_raw;
    if (threadIdx.x < 2) ((volatile LAS unsigned*)(lds + LDS_MISC))[threadIdx.x] = 0u;
    __syncthreads();
    const XcdBarrier bar = xcd_barrier_post((unsigned*)(a.ws + WS_BAR), (volatile LAS unsigned*)(lds + LDS_MISC));
    const int lo = a.ph_lo, hi = a.ph_hi;
#define IN(k) (lo <= (k) && (k) < hi)
#define SEAM(k) do { if (IN(k) && IN((k) + 1)) xcd_barrier(bar); } while (0)
    if (IN(0)) { p0_mmat(a, lds); p0_rope(a); p0_twiddle(a); p_weights_plain(a); }
    SEAM(0);
    if (IN(1)) { p_weights_prod(a, lds); p0_xconv(a); }
    fft_tables(lds);
    SEAM(1);
#pragma unroll 1
    for (int layer = 0; layer < 2; ++layer) {
        const int pb = 2 + 3 * layer;
        if (IN(pb)) {
            pg8::Gemm g{(const f16*)(a.ws + WS_XH), (const f16*)(a.ws + WS_W1T) + (size_t)layer * N1 * 1024, MROWS, N1, 1024, nullptr};
            pg8::StaticOrder S; S.init(MROWS, N1, gridDim.x, blockIdx.x);
            const bool split = (gridDim.x == 256);
            if (split) S.hi = 2048;
            Epi1 E{a.ws, a.qgain + layer * 64, a.kgain + layer * 64};
            pg8::gemm_phase<Epi1, false>(lds, g, S, E);
            if (split) {
                unsigned* tailq = (unsigned*)(a.ws + WS_BAR) + 3584 + 64 * layer;
                volatile LAS unsigned* qslot = (volatile LAS unsigned*)(lds + LDS_MISC) + 8;
                for (;;) {
                    if (threadIdx.x == 0) *qslot = __hip_atomic_fetch_add(tailq, 1u, __ATOMIC_RELAXED, __HIP_MEMORY_SCOPE_AGENT);
                    __syncthreads();
                    const unsigned q = *qslot;
                    __syncthreads();
                    if (q >= 256u) break;
                    pg8::Unit tu; S.unit_of(2048 + (int)(q >> 2), tu);
                    gemm1_tail_quadrant(lds, g.A, g.Bt, a.ws, tu.pm, tu.pn, (int)((q >> 1) & 1u), (int)(q & 1u));
                }
            }
        }
        SEAM(pb);
        if (IN(pb + 1)) {
#pragma unroll 1
            for (int part = 0; part < 2; ++part) {
                if ((part ^ (int)((blockIdx.x >> 3) & 1)) == 0) attn_phase(a, lds, layer);
                else fft_phase(a, lds);
            }
        }
        SEAM(pb + 1);
        if (IN(pb + 2)) {
            pg8::Gemm g{(const f16*)(a.ws + WS_MIX), (const f16*)(a.ws + WS_W2T) + (size_t)layer * 1024 * 1024, MROWS, 1024, 1024, (const f16*)(a.ws + WS_FOUR)};
            pg8::StaticOrder S; S.init(MROWS, 1024, gridDim.x, blockIdx.x);
            Epi2 E{a.x_prompt, a.x_sample, a.out, (f16*)(a.ws + WS_XH), (float*)(a.ws + WS_SS), layer};
            pg8::gemm_phase<Epi2, true>(lds, g, S, E);
        }
        if (layer == 0) SEAM(pb + 2);
    }
#undef IN
#undef SEAM
}

extern "C" void kernel_launch(void* const* d_in, const int* in_sizes, int n_in, void* d_out, int out_size, void* d_ws, size_t ws_size, hipStream_t stream) {
    static int grid = 0;
    if (grid == 0) {
        int dev = 0, cus = 0, per_cu = 0;
        hipGetDevice(&dev);
        hipDeviceGetAttribute(&cus, hipDeviceAttributeMultiprocessorCount, dev);
        hipFuncSetAttribute((const void*)hymba_fwd, hipFuncAttributeMaxDynamicSharedMemorySize, LDS_BYTES);
        hipOccupancyMaxActiveBlocksPerMultiprocessor(&per_cu, (const void*)hymba_fwd, NTHREADS, LDS_BYTES);
        if (per_cu < 1) { fprintf(stderr, "kernel_launch: occupancy query says %d blocks/CU\n", per_cu); per_cu = 1; }
        if (per_cu > 1) per_cu = 1;
        grid = cus * per_cu;
        if (ws_size < WS_END) { fprintf(stderr, "kernel_launch: workspace too small (%zu < %zu)\n", ws_size, (size_t)WS_END); grid = -1; }
    }
    if (grid < 0) return;
    hipMemsetAsync((char*)d_ws + WS_BAR, 0, 16384, stream);
    Args a{};
    a.x_prompt = (const float*)d_in[0]; a.x_sample = (const float*)d_in[1]; a.norm_gain = (const float*)d_in[2]; a.w_in = (const float*)d_in[3];
    a.qgain = (const float*)d_in[4]; a.kgain = (const float*)d_in[5]; a.sink = (const float*)d_in[6]; a.w_four = (const float*)d_in[7]; a.w_out = (const float*)d_in[8];
    a.out = (float*)d_out; a.ws = (unsigned char*)d_ws; a.ph_lo = 0; a.ph_hi = 8;
    void* args[] = {&a};
    hipError_t e = hipLaunchCooperativeKernel((const void*)hymba_fwd, dim3(grid), dim3(NTHREADS), args, LDS_BYTES, stream);
    if (e != hipSuccess) fprintf(stderr, "kernel_launch: cooperative launch failed: %s (grid %d)\n", hipGetErrorString(e), grid);
}
```

```cpp
#include <hip/hip_runtime.h>
#include <cstdio>
#include <cstdint>

#define LAS __attribute__((address_space(3)))
typedef _Float16 f16;
typedef _Float16 f16x8 __attribute__((ext_vector_type(8)));
typedef _Float16 f16x4 __attribute__((ext_vector_type(4)));
typedef _Float16 f16x2 __attribute__((ext_vector_type(2)));
typedef float f32x4 __attribute__((ext_vector_type(4)));
typedef float f32x2 __attribute__((ext_vector_type(2)));
typedef unsigned u32x4 __attribute__((ext_vector_type(4)));
typedef unsigned u32x2 __attribute__((ext_vector_type(2)));

constexpr int SEQ = 4096, NBATCH = 12, MROWS = NBATCH * SEQ  , DM = 1024, INW = 2304, N1 = 2816;
constexpr int ROWS_PROMPT = 4 * SEQ;
constexpr float EPS = 1e-6f;
constexpr float LOG2E = 1.4426950408889634f;
constexpr int NTHREADS = 512;
constexpr int LDS_RS = 152 * 1024 + 256;
constexpr int LDS_BYTES = LDS_RS + 9 * 256 * 2;
constexpr int LDS_MISC = 152 * 1024;
constexpr int LDS_TAB = 128 * 1024;

constexpr size_t SZ_XH = (size_t)MROWS * 1024 * 2, SZ_Q = (size_t)MROWS * 512 * 2, SZ_KV = (size_t)MROWS * 128 * 2;
constexpr size_t WS_XH = 0;
constexpr size_t WS_Q = WS_XH + SZ_XH;
constexpr size_t WS_K = WS_Q + SZ_Q;
constexpr size_t WS_V = WS_K + SZ_KV;
constexpr size_t WS_GA = WS_V + SZ_KV;
constexpr size_t WS_GF = WS_GA + SZ_Q;
constexpr size_t WS_Z = WS_GF + SZ_Q;
constexpr size_t WS_MIX = WS_Z + SZ_XH;
constexpr size_t WS_FOUR = WS_MIX + SZ_XH;
constexpr size_t WS_SS = WS_FOUR + SZ_Q;
constexpr size_t WS_W1T = WS_SS + (size_t)MROWS * 16 * 4;
constexpr size_t WS_W2T = WS_W1T + (size_t)2 * N1 * 1024 * 2;
constexpr size_t WS_MM = WS_W2T + (size_t)2 * 1024 * 1024 * 2;
constexpr size_t WS_ROPE = WS_MM + (size_t)2 * 4 * 128 * 256 * 4;
constexpr size_t WS_TW = WS_ROPE + (size_t)2 * 4096 * 32 * 4;
constexpr size_t WS_ROT = WS_TW + (size_t)4096 * 8;
constexpr size_t WS_BAR = WS_ROT + 1024;
constexpr size_t WS_END = WS_BAR + 16384;

struct Args {
    const float* x_prompt; const float* x_sample; const float* norm_gain; const float* w_in; const float* qgain; const float* kgain;
    const float* sink; const float* w_four; const float* w_out; float* out; unsigned char* ws; int ph_lo, ph_hi;
};

namespace pg8 {
constexpr int BM = 256, BK = 64, HALF = 128, HTB = HALF * BK * 2, STAGE_BYTES = 8 * HTB, NXCD = 8, WGM = 4;
__device__ __forceinline__ int lds_byte(int r, int c) { const int st = (r >> 4) * 2 + (c >> 5), rr = r & 15, cc = c & 31, ob = rr * 64 + cc * 2; return st * 1024 + (ob ^ (((ob >> 9) & 1) << 5)); }
__device__ __forceinline__ void stage_rc(int b, int& R, int& C) { const int st = b / 1024, sb = b % 1024, swz = sb ^ (((sb >> 9) & 1) << 5); R = (st >> 1) * 16 + swz / 64; C = (st & 1) * 32 + (swz % 64) / 2; }
struct Unit { int pm, pn; };
struct Gemm { const f16* A; const f16* Bt; int M, N, K; const f16* A2; };
struct StaticOrder {
    int nM, nN, nwg, G, c, hi;
    __device__ void init(int M, int N, int G_, int c_) { nM = M / BM; nN = N / BM; nwg = nM * nN; G = G_; c = c_; hi = nwg; }
    __device__ bool next(int i, Unit& u) const { const long L = (long)i * G + c; if (L >= hi) return false; unit_of((int)L, u); return true; }
    __device__ void unit_of(int L, Unit& u) const {
        int wgid = L; { const int q = nwg / NXCD, r = nwg % NXCD, xcd = wgid % NXCD, off = wgid / NXCD; wgid = (xcd < r ? xcd * (q + 1) : r * (q + 1) + (xcd - r) * q) + off; }
        const int nig = WGM * nN, gid = wgid / nig, fm = gid * WGM, gsz = (nM - fm) < WGM ? (nM - fm) : WGM;
        u.pm = fm + ((wgid % nig) % gsz); u.pn = (wgid % nig) / gsz;
    }
};

template <class Epi, bool SPLITA>
__device__ __forceinline__ void gemm_phase(LAS unsigned char* lds, const Gemm g, const StaticOrder& S, const Epi& E) {
    int tid_ = threadIdx.x; asm volatile("" : "+v"(tid_));
    const int tid = tid_, wid = __builtin_amdgcn_readfirstlane(tid >> 6), lane = tid & 63, wr = wid >> 2, wc = wid & 3, fr = lane & 15, fq = lane >> 4;
    const int K = g.K, nt = K / BK;
    unsigned voffA[2], voffF[2];
#pragma unroll
    for (int i = 0; i < 2; ++i) { int R, C; stage_rc(tid * 16 + i * 8192, R, C); voffA[i] = (unsigned)(R * K + C) * 2u; voffF[i] = (unsigned)((C >> 3) * 65536 + R * 16); }
    const size_t kstep = (size_t)(BK * 2);
    const size_t hstep = (size_t)HALF * K * 2;
    const size_t tstep = 2 * hstep;
    const unsigned ldsw = (unsigned)wid * 1024u;
    const int aoff = lds_byte(wr * 64 + fr, fq * 8), boff = lds_byte(wc * 32 + fr, fq * 8);
#define PG8_SA(b, h) (((b) * 2 + (h)) * HTB)
#define PG8_SB(b, h) ((4 + (b) * 2 + (h)) * HTB)
#define PG8_STAGE(bufoff, gbase) do { _Pragma("unroll") for (int _i = 0; _i < 2; ++_i) \
        __builtin_amdgcn_global_load_lds((const unsigned*)((const char*)(gbase) + voffA[_i]), (LAS unsigned*)(lds + (bufoff) + ldsw + _i * 8192), 16, 0, 0); } while (0)
#define PG8_STAGE_A(bufoff, pm_, kt_, half_) do { const char* _b; unsigned _v0, _v1; \
        if (SPLITA && (kt_) >= 8) { const int _k2 = (kt_) - 8; _b = (const char*)g.A2 + ((size_t)(((((pm_) >> 4) * 4 + (_k2 >> 1)) * 16 + (_k2 & 1) * 8)) * 4096 + ((pm_) & 15) * 256 + (half_) * 128) * 16; _v0 = voffF[0]; _v1 = voffF[1]; } \
        else { _b = (const char*)g.A + (size_t)(pm_) * tstep + (size_t)(half_) * hstep + (size_t)(kt_) * kstep; _v0 = voffA[0]; _v1 = voffA[1]; } \
        __builtin_amdgcn_global_load_lds((const unsigned*)(_b + _v0), (LAS unsigned*)(lds + (bufoff) + ldsw), 16, 0, 0); \
        __builtin_amdgcn_global_load_lds((const unsigned*)(_b + _v1), (LAS unsigned*)(lds + (bufoff) + ldsw + 8192), 16, 0, 0); } while (0)
#define PG8_LDA(dst, b, h) do { _Pragma("unroll") for (int m = 0; m < 4; ++m) _Pragma("unroll") for (int k = 0; k < 2; ++k) dst[m][k] = *(const LAS f16x8*)(lds + PG8_SA(b, h) + aoff + m * 2048 + k * 1024); } while (0)
#define PG8_LDB(dst, b, h) do { _Pragma("unroll") for (int n = 0; n < 2; ++n) _Pragma("unroll") for (int k = 0; k < 2; ++k) dst[n][k] = *(const LAS f16x8*)(lds + PG8_SB(b, h) + boff + n * 2048 + k * 1024); } while (0)
#define PG8_MMA(ai, bj, At, Bt) do { __builtin_amdgcn_s_setprio(1); _Pragma("unroll") for (int m = 0; m < 4; ++m) _Pragma("unroll") for (int n = 0; n < 2; ++n) _Pragma("unroll") for (int k = 0; k < 2; ++k) \
        acc[ai][bj][m][n] = __builtin_amdgcn_mfma_f32_16x16x32_f16(Bt[n][k], At[m][k], acc[ai][bj][m][n], 0, 0, 0); __builtin_amdgcn_s_setprio(0); } while (0)
#define PG8_WAIT_V(n) asm volatile("s_waitcnt vmcnt(" #n ")" ::: "memory")
#define PG8_WAIT_L(n) asm volatile("s_waitcnt lgkmcnt(" #n ")" ::: "memory")
#define PG8_BAR __builtin_amdgcn_s_barrier()
#define PG8_SCHED __builtin_amdgcn_sched_barrier(0)
    Unit cur, nxt; int ui = 0;
    if (!S.next(0, cur)) return;
    E.prepare(lds, S, tid);
    f32x4 acc[2][2][4][2];
#pragma unroll
    for (int a = 0; a < 2; ++a)
#pragma unroll
        for (int b = 0; b < 2; ++b)
#pragma unroll
            for (int m = 0; m < 4; ++m)
#pragma unroll
                for (int n = 0; n < 2; ++n) acc[a][b][m][n] = (f32x4){0.f, 0.f, 0.f, 0.f};
    f16x8 At[4][2], B0[2][2], B1[2][2];
    const char* cB = (const char*)g.Bt + (size_t)cur.pn * tstep;
    PG8_STAGE(PG8_SB(0, 0), cB); PG8_STAGE(PG8_SB(0, 1), cB + hstep); PG8_STAGE_A(PG8_SA(0, 0), cur.pm, 0, 0); PG8_STAGE_A(PG8_SA(0, 1), cur.pm, 0, 1);
    if (wr == 1) PG8_BAR;
    PG8_WAIT_V(2); PG8_BAR;
    PG8_STAGE(PG8_SB(1, 0), cB + kstep); PG8_STAGE_A(PG8_SA(1, 0), cur.pm, 1, 0); PG8_STAGE(PG8_SB(1, 1), cB + hstep + kstep);
    PG8_WAIT_V(6); PG8_BAR;
    for (;;) {
        const bool has_next = S.next(ui + 1, nxt);
        const int npm = has_next ? nxt.pm : cur.pm; const char* nB = has_next ? (const char*)g.Bt + (size_t)nxt.pn * tstep : cB;
        for (int t = 0; t < nt; t += 2) {
            const bool last = (t == nt - 2);
            const int pm2 = last ? npm : cur.pm, kt2 = last ? 0 : t + 2;
            const char* b2 = last ? nB : cB + (size_t)(t + 2) * kstep; const char* b3 = b2 + kstep;
            PG8_LDB(B0, 0, 0); PG8_LDB(B1, 0, 1); PG8_SCHED; PG8_LDA(At, 0, 0); PG8_STAGE_A(PG8_SA(1, 1), cur.pm, t + 1, 1);
            PG8_WAIT_V(8); PG8_WAIT_L(0); PG8_BAR; PG8_MMA(0, 0, At, B0); PG8_MMA(0, 1, At, B1); PG8_BAR; PG8_SCHED;
            PG8_LDA(At, 0, 1); PG8_STAGE(PG8_SB(0, 0), b2); PG8_STAGE(PG8_SB(0, 1), b2 + hstep); PG8_STAGE_A(PG8_SA(0, 0), pm2, kt2, 0);
            PG8_WAIT_V(8); PG8_WAIT_L(0); PG8_BAR; PG8_MMA(1, 0, At, B0); PG8_MMA(1, 1, At, B1); PG8_BAR; PG8_SCHED;
            PG8_LDB(B0, 1, 0); PG8_LDB(B1, 1, 1); PG8_SCHED; PG8_LDA(At, 1, 0); PG8_STAGE_A(PG8_SA(0, 1), pm2, kt2, 1);
            PG8_WAIT_V(8); PG8_WAIT_L(0); PG8_BAR; PG8_MMA(0, 0, At, B0); PG8_MMA(0, 1, At, B1); PG8_BAR; PG8_SCHED;
            PG8_LDA(At, 1, 1); PG8_STAGE(PG8_SB(1, 0), b3); PG8_STAGE(PG8_SB(1, 1), b3 + hstep); PG8_STAGE_A(PG8_SA(1, 0), pm2, kt2 + 1, 0);
            PG8_WAIT_V(8); PG8_WAIT_L(0); PG8_BAR; PG8_MMA(1, 0, At, B0); PG8_MMA(1, 1, At, B1); PG8_BAR; PG8_SCHED;
        }
        if (wr == 0) PG8_BAR;
        E(acc, cur, ui, lds, wr, wc, fr, fq);
        if (!has_next) break;
#pragma unroll
        for (int a = 0; a < 2; ++a)
#pragma unroll
            for (int b = 0; b < 2; ++b)
#pragma unroll
                for (int m = 0; m < 4; ++m)
#pragma unroll
                    for (int n = 0; n < 2; ++n) acc[a][b][m][n] = (f32x4){0.f, 0.f, 0.f, 0.f};
        cur = nxt; cB = nB; ++ui;
        if (wr == 1) PG8_BAR;
    }
    PG8_WAIT_V(0);
    PG8_BAR;
#undef PG8_SA
#undef PG8_SB
#undef PG8_STAGE
#undef PG8_STAGE_A
#undef PG8_LDA
#undef PG8_LDB
#undef PG8_MMA
#undef PG8_WAIT_V
#undef PG8_WAIT_L
#undef PG8_BAR
#undef PG8_SCHED
}
}

__host__ __device__ __forceinline__ int colmap(int rho) { const int bj = rho >> 7, wc = (rho >> 5) & 3, n = (rho >> 4) & 1, fq = (rho >> 2) & 3, j = rho & 3; return 64 * wc + 32 * bj + 8 * fq + 4 * n + j; }

__device__ __forceinline__ float silu_f(float z) { return z * __builtin_amdgcn_rcpf(1.0f + __builtin_amdgcn_exp2f(-LOG2E * z)); }
__device__ __forceinline__ u32x4 pack8(const float* v) {
    f16x8 h;
#pragma unroll
    for (int i = 0; i < 8; ++i) h[i] = (f16)v[i];
    return __builtin_bit_cast(u32x4, h);
}

__device__ __forceinline__ void gemm1_tail_quadrant(LAS unsigned char* lds, const f16* A, const f16* Bt, unsigned char* ws, int pm, int pn, int ai, int bj) {
    using namespace pg8;
    int tid_ = threadIdx.x; asm volatile("" : "+v"(tid_));
    const int tid = tid_, wid = __builtin_amdgcn_readfirstlane(tid >> 6), lane = tid & 63, wr = wid >> 2, wc = wid & 3, fr = lane & 15, fq = lane >> 4;
    constexpr int K = 1024, NT = K / BK;
    unsigned voff[2];
#pragma unroll
    for (int i = 0; i < 2; ++i) { int R, C; stage_rc(tid * 16 + i * 8192, R, C); voff[i] = (unsigned)(R * K + C) * 2u; }
    const char* abase = (const char*)A + ((size_t)pm * 256 + ai * 128) * K * 2;
    const char* bbase = (const char*)Bt + ((size_t)pn * 256 + bj * 128) * K * 2;
    const unsigned ldsw = (unsigned)wid * 1024u;
    const int aoff = lds_byte(wr * 64 + fr, fq * 8), boff = lds_byte(wc * 32 + fr, fq * 8);
#define QSTAGE(s_, kt_) do { _Pragma("unroll") for (int _i = 0; _i < 2; ++_i) { \
        __builtin_amdgcn_global_load_lds((const unsigned*)(abase + (size_t)(kt_) * (BK * 2) + voff[_i]), (LAS unsigned*)(lds + (s_) * 32768 + ldsw + _i * 8192), 16, 0, 0); \
        __builtin_amdgcn_global_load_lds((const unsigned*)(bbase + (size_t)(kt_) * (BK * 2) + voff[_i]), (LAS unsigned*)(lds + (s_) * 32768 + 16384 + ldsw + _i * 8192), 16, 0, 0); } } while (0)
    f32x4 acc[4][2];
#pragma unroll
    for (int m = 0; m < 4; ++m)
#pragma unroll
        for (int n = 0; n < 2; ++n) acc[m][n] = (f32x4){0.f, 0.f, 0.f, 0.f};
    QSTAGE(0, 0); QSTAGE(1, 1); QSTAGE(2, 2);
#pragma unroll 1
    for (int t = 0; t < NT; ++t) {
        if (t <= NT - 3) asm volatile("s_waitcnt vmcnt(8)" ::: "memory"); else if (t == NT - 2) asm volatile("s_waitcnt vmcnt(4)" ::: "memory"); else asm volatile("s_waitcnt vmcnt(0)" ::: "memory");
        __builtin_amdgcn_s_barrier();
        if (t + 3 < NT) QSTAGE((t + 3) & 3, t + 3);
        LAS unsigned char* sl = lds + (t & 3) * 32768;
        f16x8 At[4][2], Bf[2][2];
#pragma unroll
        for (int m = 0; m < 4; ++m)
#pragma unroll
            for (int k = 0; k < 2; ++k) At[m][k] = *(const LAS f16x8*)(sl + aoff + m * 2048 + k * 1024);
#pragma unroll
        for (int n = 0; n < 2; ++n)
#pragma unroll
            for (int k = 0; k < 2; ++k) Bf[n][k] = *(const LAS f16x8*)(sl + 16384 + boff + n * 2048 + k * 1024);
#pragma unroll
        for (int m = 0; m < 4; ++m)
#pragma unroll
            for (int n = 0; n < 2; ++n)
#pragma unroll
                for (int k = 0; k < 2; ++k) acc[m][n] = __builtin_amdgcn_mfma_f32_16x16x32_f16(Bf[n][k], At[m][k], acc[m][n], 0, 0, 0);
    }
#undef QSTAGE
    const float* SS = (const float*)(ws + WS_SS); f16* Z = (f16*)(ws + WS_Z);
    const int row0 = pm * 256 + ai * 128 + wr * 64 + fr;
    f32x4 part[4];
#pragma unroll
    for (int m = 0; m < 4; ++m) part[m] = *(const f32x4*)(SS + (size_t)(row0 + m * 16) * 16 + 4 * fq);
#pragma unroll
    for (int m = 0; m < 4; ++m) {
        float t = (part[m][0] + part[m][1]) + (part[m][2] + part[m][3]);
        t += __shfl_xor(t, 16); t += __shfl_xor(t, 32);
        const float rs = __builtin_amdgcn_rsqf(t * (1.0f / 1024.0f) + EPS);
        const int row = row0 + m * 16;
        float v[8];
#pragma unroll
        for (int e = 0; e < 8; ++e) v[e] = acc[m][e >> 2][e & 3] * rs;
        const int cg8 = 8 * (wc & 1) + 4 * bj + fq;
        f16* p = Z + (((size_t)(((row >> 12) * 4 + (pn - 7)) * 16 + cg8) * 4096 + (row & 4095)) * 2 + (wc >> 1)) * 8;
        *(u32x4*)p = pack8(v);
    }
    asm volatile("s_waitcnt vmcnt(0)" ::: "memory");
    __syncthreads();
}

struct Epi1 {
    unsigned char* __restrict__ ws; const float* __restrict__ qg; const float* __restrict__ kg;
    __device__ __forceinline__ void prepare(LAS unsigned char* lds, const pg8::StaticOrder& S, int tid) const {
        const float* SS = (const float*)(ws + WS_SS);
        f32x4 p0[9], p1[9];
#pragma unroll
        for (int i = 0; i < 9; ++i) {
            pg8::Unit u; p0[i] = (f32x4){0.f, 0.f, 0.f, 0.f}; p1[i] = p0[i];
            if (S.next(i, u)) { const float* sp = SS + (size_t)(u.pm * 256 + (tid >> 1)) * 16 + (tid & 1) * 8; p0[i] = *(const f32x4*)sp; p1[i] = *(const f32x4*)(sp + 4); }
        }
#pragma unroll
        for (int i = 0; i < 9; ++i) {
            float t = ((p0[i][0] + p0[i][1]) + (p0[i][2] + p0[i][3])) + ((p1[i][0] + p1[i][1]) + (p1[i][2] + p1[i][3]));
            t += __shfl_xor(t, 1);
            if ((tid & 1) == 0) ((LAS f16*)(lds + LDS_RS))[i * 256 + (tid >> 1)] = (f16)(1.0f / sqrtf(t * (1.0f / 1024.0f) + EPS));
        }
        __syncthreads();
    }
    __device__ __forceinline__ void operator()(const f32x4 (&acc)[2][2][4][2], const pg8::Unit& u, int ui, LAS unsigned char* lds, int wr, int wc, int fr_, int fq_) const {
        int fr = fr_, fq = fq_; asm volatile("" : "+v"(fr), "+v"(fq));
        const float* ropeC = (const float*)(ws + WS_ROPE); const float* ropeS = ropeC + 4096 * 32; const float* rot = (const float*)(ws + WS_ROT);
        f16* Q = (f16*)(ws + WS_Q); f16* K = (f16*)(ws + WS_K); f16* V = (f16*)(ws + WS_V); f16* GA = (f16*)(ws + WS_GA); f16* GF = (f16*)(ws + WS_GF); f16* Z = (f16*)(ws + WS_Z);
        const int pn = u.pn;
        const bool is_qk = (pn <= 1) || (pn == 2 && wc < 2);
        const int row0 = u.pm * 256 + wr * 64 + fr;
        float rsv[8];
#pragma unroll
        for (int i = 0; i < 8; ++i) rsv[i] = (float)((const LAS f16*)(lds + LDS_RS))[ui * 256 + wr * 64 + fr + (i >> 2) * 128 + (i & 3) * 16];
        if (is_qk) {
            const float* gain = (pn <= 1) ? qg : kg;
            const float oscale = (pn <= 1) ? (0.125f * LOG2E) : 1.0f;
            f32x4 gv[2][2];
#pragma unroll
            for (int bj = 0; bj < 2; ++bj)
#pragma unroll
                for (int n = 0; n < 2; ++n) gv[bj][n] = *(const f32x4*)(gain + 32 * bj + 8 * fq + 4 * n);
            const int pos0 = row0 & (SEQ - 1);
            f32x4 cs[2], sn[2], c16[2], s16[2];
#pragma unroll
            for (int n = 0; n < 2; ++n) {
                cs[n] = *(const f32x4*)(ropeC + pos0 * 32 + 8 * fq + 4 * n); sn[n] = *(const f32x4*)(ropeS + pos0 * 32 + 8 * fq + 4 * n);
                c16[n] = *(const f32x4*)(rot + 8 * fq + 4 * n); s16[n] = *(const f32x4*)(rot + 32 + 8 * fq + 4 * n);
            }
#pragma unroll
            for (int ai = 0; ai < 2; ++ai) {
                if (ai == 1) {
#pragma unroll
                    for (int k = 0; k < 5; ++k)
#pragma unroll
                        for (int n = 0; n < 2; ++n) { const f32x4 c2 = cs[n] * c16[n] - sn[n] * s16[n]; sn[n] = sn[n] * c16[n] + cs[n] * s16[n]; cs[n] = c2; }
                }
#pragma unroll
                for (int m = 0; m < 4; ++m) {
                    const int row = row0 + ai * 128 + m * 16;
                    const float rs = rsv[ai * 4 + m];
                    float v[2][8];
#pragma unroll
                    for (int bj = 0; bj < 2; ++bj)
#pragma unroll
                        for (int e = 0; e < 8; ++e) v[bj][e] = acc[ai][bj][m][e >> 2][e & 3] * rs;
                    float ss = 0.f;
#pragma unroll
                    for (int bj = 0; bj < 2; ++bj)
#pragma unroll
                        for (int e = 0; e < 8; ++e) ss += v[bj][e] * v[bj][e];
                    ss += __shfl_xor(ss, 16); ss += __shfl_xor(ss, 32);
                    const float rn = __builtin_amdgcn_rsqf(ss * (1.0f / 64.0f) + EPS);
                    float o0[8], o1[8];
#pragma unroll
                    for (int e = 0; e < 8; ++e) {
                        const float cc = cs[e >> 2][e & 3], sv = sn[e >> 2][e & 3];
                        const float q0 = v[0][e] * rn * gv[0][e >> 2][e & 3], q1 = v[1][e] * rn * gv[1][e >> 2][e & 3];
                        o0[e] = (q0 * cc - q1 * sv) * oscale; o1[e] = (q1 * cc + q0 * sv) * oscale;
                    }
                    f16* p = (pn <= 1) ? Q + (size_t)row * 512 + (pn * 4 + wc) * 64 + 8 * fq : K + (size_t)row * 128 + wc * 64 + 8 * fq;
                    *(u32x4*)p = pack8(o0); *(u32x4*)(p + 32) = pack8(o1);
                    if (m < 3) {
#pragma unroll
                        for (int n = 0; n < 2; ++n) { const f32x4 c2 = cs[n] * c16[n] - sn[n] * s16[n]; sn[n] = sn[n] * c16[n] + cs[n] * s16[n]; cs[n] = c2; }
                    }
                }
            }
        } else {
#pragma unroll
            for (int ai = 0; ai < 2; ++ai)
#pragma unroll
                for (int m = 0; m < 4; ++m) {
                    const int row = row0 + ai * 128 + m * 16;
                    const float rs = rsv[ai * 4 + m];
                    float v[2][8];
#pragma unroll
                    for (int bj = 0; bj < 2; ++bj)
#pragma unroll
                        for (int e = 0; e < 8; ++e) v[bj][e] = acc[ai][bj][m][e >> 2][e & 3] * rs;
                    if (pn == 2) {
                        f16* p = V + (size_t)row * 128 + (wc - 2) * 64 + 8 * fq; *(u32x4*)p = pack8(v[0]); *(u32x4*)(p + 32) = pack8(v[1]);
                    } else if (pn <= 4) {
#pragma unroll
                        for (int bj = 0; bj < 2; ++bj)
#pragma unroll
                            for (int e = 0; e < 8; ++e) v[bj][e] = silu_f(v[bj][e]);
                        f16* p = GA + (size_t)row * 512 + (pn - 3) * 256 + wc * 64 + 8 * fq;
                        *(u32x4*)p = pack8(v[0]); *(u32x4*)(p + 32) = pack8(v[1]);
                    } else if (pn <= 6) {
#pragma unroll
                        for (int bj = 0; bj < 2; ++bj)
#pragma unroll
                            for (int e = 0; e < 8; ++e) v[bj][e] = silu_f(v[bj][e]);
                        const int gq = 2 * (pn - 5) + (wc >> 1), cg8 = 8 * (wc & 1) + fq;
                        f16* p = GF + ((size_t)(((row >> 12) * 4 + gq) * 16 + cg8) * 4096 + (row & 4095)) * 8;
                        *(u32x4*)p = pack8(v[0]); *(u32x4*)(p + (size_t)4 * 4096 * 8) = pack8(v[1]);
                    } else {
                        const int cg8 = 8 * (wc & 1) + fq;
                        f16* p = Z + (((size_t)(((row >> 12) * 4 + (pn - 7)) * 16 + cg8) * 4096 + (row & 4095)) * 2 + (wc >> 1)) * 8;
                        *(u32x4*)p = pack8(v[0]); *(u32x4*)(p + (size_t)4 * 4096 * 16) = pack8(v[1]);
                    }
                }
        }
    }
};

struct Epi2 {
    const float* __restrict__ xp; const float* __restrict__ xs; float* __restrict__ out; f16* XH; float* __restrict__ SS; int layer;
    __device__ __forceinline__ void prepare(LAS unsigned char*, const pg8::StaticOrder&, int) const {}
    __device__ __forceinline__ void operator()(const f32x4 (&acc)[2][2][4][2], const pg8::Unit& u, int, LAS unsigned char*, int wr, int wc, int fr_, int fq_) const {
        int fr = fr_, fq = fq_; asm volatile("" : "+v"(fr), "+v"(fq));
        const int row0 = u.pm * 256 + wr * 64 + fr, col0 = u.pn * 256 + wc * 64 + 8 * fq;
        if (layer == 0) {
#pragma unroll
            for (int ai = 0; ai < 2; ++ai) {
                f16x8 xh[4][2];
#pragma unroll
                for (int m = 0; m < 4; ++m)
#pragma unroll
                    for (int bj = 0; bj < 2; ++bj) xh[m][bj] = *(const f16x8*)(XH + (size_t)(row0 + ai * 128 + m * 16) * DM + col0 + bj * 32);
#pragma unroll
                for (int m = 0; m < 4; ++m) {
                    const int row = row0 + ai * 128 + m * 16;
                    float ss = 0.f;
#pragma unroll
                    for (int bj = 0; bj < 2; ++bj) {
                        f16x8 hv;
#pragma unroll
                        for (int e = 0; e < 8; ++e) { hv[e] = (f16)((float)xh[m][bj][e] + acc[ai][bj][m][e >> 2][e & 3]); const float tr = (float)hv[e]; ss += tr * tr; }
                        *(f16x8*)(XH + (size_t)row * DM + col0 + bj * 32) = hv;
                    }
                    ss += __shfl_xor(ss, 16); ss += __shfl_xor(ss, 32);
                    if (fq == 0) SS[(size_t)row * 16 + u.pn * 4 + wc] = ss;
                }
            }
        } else {
            f16x8 xh[2][4][2];
#pragma unroll
            for (int ai = 0; ai < 2; ++ai)
#pragma unroll
                for (int m = 0; m < 4; ++m)
#pragma unroll
                    for (int bj = 0; bj < 2; ++bj) xh[ai][m][bj] = *(const f16x8*)(XH + (size_t)(row0 + ai * 128 + m * 16) * DM + col0 + bj * 32);
#pragma unroll
            for (int ai = 0; ai < 2; ++ai)
#pragma unroll
                for (int m = 0; m < 4; ++m) {
                    float* dst = out + (size_t)(row0 + ai * 128 + m * 16) * DM + col0;
#pragma unroll
                    for (int bj = 0; bj < 2; ++bj) {
                        f32x4 x0, x1;
#pragma unroll
                        for (int e = 0; e < 4; ++e) { x0[e] = (float)xh[ai][m][bj][e] + acc[ai][bj][m][0][e]; x1[e] = (float)xh[ai][m][bj][4 + e] + acc[ai][bj][m][1][e]; }
                        *(f32x4*)(dst + bj * 32) = x0; *(f32x4*)(dst + bj * 32 + 4) = x1;
                    }
                }
        }
    }
};

__device__ void p0_mmat(const Args& a, LAS unsigned char* lds) {
    LAS float* ct = (LAS float*)lds; LAS float* st = ct + 128;
    int tid_ = threadIdx.x; asm volatile("" : "+v"(tid_)); const int tid = tid_;
    if (tid < 128) { float s, c; sincospif((float)tid * (1.0f / 64.0f), &s, &c); ct[tid] = c; st[tid] = s; }
    __syncthreads();
    float* MM = (float*)(a.ws + WS_MM);
    const int total = 2 * 4 * 128 * 64;
    for (int idx = blockIdx.x * NTHREADS + tid; idx < total; idx += gridDim.x * NTHREADS) {
        const int d4 = idx & 63, cp = (idx >> 6) & 127, lg = idx >> 13;
        const float* W = a.w_four + (size_t)lg * 128 * 128 + 4 * (d4 & 31);
        const LAS float* tb = (d4 < 32) ? ct : st;
        f32x4 acc = {0.f, 0.f, 0.f, 0.f};
#pragma unroll 8
        for (int c = 0; c < 128; ++c) acc += *(const f32x4*)(W + c * 128) * tb[(cp * c) & 127];
        *(f32x4*)(MM + ((size_t)(lg * 128 + cp) * 256 + 4 * d4)) = acc * 0.08838834764831845f;
    }
    __syncthreads();
}
__device__ void p0_rope(const Args& a) {
    float* rc = (float*)(a.ws + WS_ROPE); float* rsn = rc + 4096 * 32;
    for (int idx = blockIdx.x * NTHREADS + threadIdx.x; idx < 4096 * 32; idx += gridDim.x * NTHREADS) {
        const int i = idx & 31, pos = idx >> 5;
        const float inv_freq = 1.0f / powf(10000.0f, (float)i * (1.0f / 32.0f));
        const float ang = (float)pos * inv_freq;
        float s, c; sincosf(ang, &s, &c);
        rc[idx] = c; rsn[idx] = s;
    }
    if (blockIdx.x == 0 && threadIdx.x < 64) {
        float* rot = (float*)(a.ws + WS_ROT);
        const int i = threadIdx.x & 31, step = (threadIdx.x < 32) ? 16 : 128;
        const float inv_freq = 1.0f / powf(10000.0f, (float)i * (1.0f / 32.0f));
        float s, c; sincosf((float)step * inv_freq, &s, &c);
        rot[(threadIdx.x < 32 ? 0 : 64) + i] = c; rot[(threadIdx.x < 32 ? 32 : 96) + i] = s;
    }
}
__device__ void p0_xconv(const Args& a) {
    f16* XH = (f16*)(a.ws + WS_XH); float* SS = (float*)(a.ws + WS_SS);
    int tid_ = threadIdx.x; asm volatile("" : "+v"(tid_));
    const int lane = tid_ & 63, wv = tid_ >> 6;
    const int nwv = (int)gridDim.x * 8;
    for (int row0 = (int)blockIdx.x * 8 + wv; row0 < MROWS; row0 += 4 * nwv) {
        f32x4 v[4][4];
#pragma unroll
        for (int r = 0; r < 4; ++r) {
            const int row = row0 + r * nwv;
            if (row < MROWS) {
                const float* src = (row < ROWS_PROMPT) ? a.x_prompt + (size_t)row * DM : a.x_sample + (size_t)(row - ROWS_PROMPT) * DM;
#pragma unroll
                for (int i = 0; i < 4; ++i) v[r][i] = __builtin_nontemporal_load((const f32x4*)(src + i * 256 + lane * 4));
            }
        }
#pragma unroll
        for (int r = 0; r < 4; ++r) {
            const int row = row0 + r * nwv;
            if (row < MROWS) {
                float ss = 0.f;
#pragma unroll
                for (int i = 0; i < 4; ++i) {
                    const f32x4 x = v[r][i];
                    ss += (x[0] * x[0] + x[1] * x[1]) + (x[2] * x[2] + x[3] * x[3]);
                    f16x4 h; h[0] = (f16)x[0]; h[1] = (f16)x[1]; h[2] = (f16)x[2]; h[3] = (f16)x[3];
                    *(f16x4*)(XH + (size_t)row * DM + i * 256 + lane * 4) = h;
                }
#pragma unroll
                for (int o = 1; o < 64; o <<= 1) ss += __shfl_xor(ss, o);
                if (lane < 16) SS[(size_t)row * 16 + lane] = (lane == 0) ? ss : 0.f;
            }
        }
    }
}
__device__ void p_weights_plain(const Args& a) {
    int tid_ = threadIdx.x; asm volatile("" : "+v"(tid_)); const int tid = tid_;
    const int cq = tid & 63, rq = tid >> 6;
    const int lc0 = 4 * cq;
    const int rho0 = 128 * ((lc0 >> 5) & 1) + 32 * (lc0 >> 6) + 16 * ((lc0 >> 2) & 1) + 4 * ((lc0 >> 3) & 3);
    f16* W1T = (f16*)(a.ws + WS_W1T); f16* W2T = (f16*)(a.ws + WS_W2T);
    for (int u = blockIdx.x; u < 704; u += gridDim.x) {
        const float* w; f16* dst; int ldw, col; f32x4 gn = {1.f, 1.f, 1.f, 1.f};
        if (u < 448) {
            const int l = u / 224, r = u % 224, pn = r >> 5, kblk = r & 31, k0 = kblk * 32 + 4 * rq;
            const int L = pn * 256 + lc0; col = (L < 1280) ? L : L + 512; ldw = INW;
            w = a.w_in + (size_t)l * DM * INW + (size_t)k0 * INW;
            gn = *(const f32x4*)(a.norm_gain + l * DM + k0);
            dst = W1T + ((size_t)l * N1 + pn * 256 + rho0) * 1024 + k0;
        } else {
            const int r = u - 448, l = r >> 7, pn = (r >> 5) & 3, kblk = r & 31, k0 = kblk * 32 + 4 * rq;
            col = pn * 256 + lc0; ldw = DM;
            w = a.w_out + (size_t)l * DM * DM + (size_t)k0 * DM;
            dst = W2T + ((size_t)l * DM + pn * 256 + rho0) * 1024 + k0;
        }
        f32x4 x[4];
#pragma unroll
        for (int i = 0; i < 4; ++i) x[i] = *(const f32x4*)(w + (size_t)i * ldw + col) * gn[i];
#pragma unroll
        for (int j = 0; j < 4; ++j) {
            f16x4 o;
#pragma unroll
            for (int i = 0; i < 4; ++i) o[i] = (f16)x[i][j];
            *(f16x4*)(dst + (size_t)j * 1024) = o;
        }
    }
}
__device__ void p_weights_prod(const Args& a, LAS unsigned char* lds) {
    int tid_ = threadIdx.x; asm volatile("" : "+v"(tid_)); const int tid = tid_;
    const int cq = tid & 63, rq = tid >> 6;
    const int lc0 = 4 * cq;
    const int rho0 = 128 * ((lc0 >> 5) & 1) + 32 * (lc0 >> 6) + 16 * ((lc0 >> 2) & 1) + 4 * ((lc0 >> 3) & 3);
    f16* W1T = (f16*)(a.ws + WS_W1T); const float* MM = (const float*)(a.ws + WS_MM);
    LAS float* wt = (LAS float*)lds;
    LAS float* mmt = (LAS float*)(lds + 16384);
    for (int u = blockIdx.x; u < 256; u += gridDim.x) {
        const int l = u >> 7, g = (u >> 5) & 3, kblk = u & 31, pn = 7 + g;
        __syncthreads();
        {
            const int rr = tid >> 4, c8 = (tid & 15) * 8;
            const float* src = a.w_in + (size_t)l * DM * INW + (size_t)(kblk * 32 + rr) * INW + 1280 + g * 128 + c8;
            const f32x4* msrc = (const f32x4*)(MM + (size_t)(l * 4 + g) * 128 * 256) + tid;
            f32x4 mreg[16];
#pragma unroll
            for (int j = 0; j < 16; ++j) mreg[j] = msrc[j * NTHREADS];
            *(LAS f32x4*)(wt + rr * 128 + c8) = *(const f32x4*)src; *(LAS f32x4*)(wt + rr * 128 + c8 + 4) = *(const f32x4*)(src + 4);
#pragma unroll
            for (int j = 0; j < 16; ++j) ((LAS f32x4*)mmt)[tid + j * NTHREADS] = mreg[j];
        }
        __syncthreads();
        f32x4 acc[4];
#pragma unroll
        for (int r2 = 0; r2 < 4; ++r2) acc[r2] = (f32x4){0.f, 0.f, 0.f, 0.f};
#pragma unroll 2
        for (int c0 = 0; c0 < 128; c0 += 4) {
            f32x4 w4[4], m4[4];
#pragma unroll
            for (int r2 = 0; r2 < 4; ++r2) w4[r2] = *(const LAS f32x4*)(wt + (4 * rq + r2) * 128 + c0);
#pragma unroll
            for (int cc = 0; cc < 4; ++cc) m4[cc] = *(const LAS f32x4*)(mmt + (c0 + cc) * 256 + lc0);
#pragma unroll
            for (int r2 = 0; r2 < 4; ++r2)
#pragma unroll
                for (int cc = 0; cc < 4; ++cc) acc[r2] += m4[cc] * w4[r2][cc];
        }
        const int k0 = kblk * 32 + 4 * rq;
        const f32x4 gn = *(const f32x4*)(a.norm_gain + l * DM + k0);
#pragma unroll
        for (int j = 0; j < 4; ++j) {
            f16x4 o;
#pragma unroll
            for (int r2 = 0; r2 < 4; ++r2) o[r2] = (f16)(acc[r2][j] * gn[r2]);
            *(f16x4*)(W1T + ((size_t)l * N1 + pn * 256 + rho0 + j) * 1024 + k0) = o;
        }
    }
    __syncthreads();
}

typedef float f32x16 __attribute__((ext_vector_type(16)));
typedef short s16x4 __attribute__((ext_vector_type(4)));
__device__ __forceinline__ f16x8 tr_pair(LAS unsigned char* p0, LAS unsigned char* p1) {
    const s16x4 lo = __builtin_amdgcn_ds_read_tr16_b64_v4i16((LAS s16x4*)p0);
    const s16x4 hi = __builtin_amdgcn_ds_read_tr16_b64_v4i16((LAS s16x4*)p1);
    return __builtin_bit_cast(f16x8, __builtin_shufflevector(lo, hi, 0, 1, 2, 3, 4, 5, 6, 7));
}
__device__ __forceinline__ float max3f(float a, float b, float c) { float d; asm("v_max3_f32 %0, %1, %2, %3" : "=v"(d) : "v"(a), "v"(b), "v"(c)); return d; }
__device__ __forceinline__ f16x8 pack_p(const f32x16& p, int s) {
    f16x8 r;
#pragma unroll
    for (int j = 0; j < 8; ++j) r[j] = (f16)p[8 * s + j];
    return r;
}
constexpr int FILL_STEP = 4, ATT_V = 65536;
__device__ void attn_phase(const Args& a, LAS unsigned char* lds, int layer) {
    int tid_ = threadIdx.x; asm volatile("" : "+v"(tid_)); const int tid = tid_;
    const int lane = tid & 63, wid = __builtin_amdgcn_readfirstlane(tid >> 6), r = lane & 31, h = lane >> 5;
    const int hq = wid >> 1, qh = wid & 1;
    const f16* Q = (const f16*)(a.ws + WS_Q); const f16* K = (const f16*)(a.ws + WS_K); const f16* V = (const f16*)(a.ws + WS_V);
    const f16* GA = (const f16*)(a.ws + WS_GA); f16* MIX = (f16*)(a.ws + WS_MIX);
    const int per = (1536 + (int)gridDim.x - 1) / (int)gridDim.x;
    const int u_lo = blockIdx.x * per, u_hi = (u_lo + per < 1536) ? u_lo + per : 1536;
    int unit = u_lo;
    if (unit >= 1536) return;
    float m0;
    {
        float gq = fabsf(a.qgain[layer * 64 + lane]), gk = fabsf(a.kgain[layer * 64 + lane]);
#pragma unroll
        for (int o = 1; o < 64; o <<= 1) { gq = fmaxf(gq, __shfl_xor(gq, o)); gk = fmaxf(gk, __shfl_xor(gk, o)); }
        m0 = __builtin_bit_cast(float, __builtin_amdgcn_readfirstlane(__builtin_bit_cast(int, 8.0f * gq * gk * LOG2E - 8.0f)));
    }
    u32x4 kreg[5], vreg[5];
#define ATT_LOAD(un) do { const int _qb = (un) & 63, _kvh = ((un) >> 6) & 1, _b = (un) >> 7, _q0 = _qb * 64; \
        _Pragma("unroll") for (int j = 0; j < 5; ++j) { const int i = tid + NTHREADS * j, rr = i >> 3, c = i & 7, kp0 = _q0 - 128 + rr, kp = kp0 < 0 ? 0 : (kp0 > SEQ - 1 ? SEQ - 1 : kp0); \
            const size_t off = ((size_t)(_b * SEQ + kp)) * 128 + _kvh * 64 + c * 8; kreg[j] = *(const u32x4*)(K + off); vreg[j] = *(const u32x4*)(V + off); } \
        } while (0)
    u32x4 kn, vn;
    f16x8 qf[4];
#define ATT_QLOAD(un) do { const int _qp = ((un) & 63) * 64 + 32 * qh + r, _head = (((un) >> 6) & 1) * 4 + hq; const size_t _grow = (size_t)(((un) >> 7) * SEQ + _qp); \
        _Pragma("unroll") for (int s = 0; s < 4; ++s) qf[s] = *(const f16x8*)(Q + _grow * 512 + _head * 64 + 16 * s + 8 * h); } while (0)
    ATT_QLOAD(unit);
    const int blk = (lane >> 4) & 1, tq = (lane & 15) >> 2, tp = lane & 3;
#pragma unroll 1
    for (; unit < u_hi; ++unit) {
        const int qb = unit & 63, kvh = (unit >> 6) & 1, b = unit >> 7, q0 = qb * 64;
        const int head = kvh * 4 + hq, qp = q0 + 32 * qh + r;
        const size_t grow = (size_t)(b * SEQ + qp);
        const float sinkv = a.sink[layer * 8 + head];
        if (unit == u_lo || qb == 0) {
            ATT_LOAD(unit);
            __syncthreads();
#pragma unroll
            for (int j = 0; j < 5; ++j) {
                const int i = tid + NTHREADS * j, c = i & 7, rr = (q0 - 128 + (i >> 3)) & 511;
                *(LAS u32x4*)(lds + rr * 128 + ((c ^ ((rr >> 1) & 7)) << 4)) = kreg[j];
                *(LAS u32x4*)(lds + ATT_V + rr * 128 + (((c >> 1) ^ (rr & 3)) << 5) + ((c & 1) << 4)) = vreg[j];
            }
        }
        __syncthreads();
        {
            const int kp0 = q0 + 192 + (tid >> 3), kp = kp0 > SEQ - 1 ? SEQ - 1 : kp0;
            const size_t off = ((size_t)(b * SEQ + kp)) * 128 + kvh * 64 + (tid & 7) * 8; kn = *(const u32x4*)(K + off); vn = *(const u32x4*)(V + off);
        }
        f32x16 O0, O1;
#pragma unroll
        for (int i = 0; i < 16; ++i) { O0[i] = 0.f; O1[i] = 0.f; }
        float l = h ? 0.0f : __builtin_amdgcn_exp2f(sinkv * LOG2E - m0);
        const int lo_d = (-qp > -128) ? -qp : -128, hi_d = (SEQ - 1 - qp < 128) ? (SEQ - 1 - qp) : 128;
        const int ksw = (r >> 1) & 7;
        LAS unsigned char* kbase = lds + r * 128;
        LAS unsigned char* vbase = lds + ATT_V + (4 * h + tq) * 128 + tp * 8;
        const int k0w = q0 - 128 + 32 * qh;
        const int vsw0 = ((0 + blk) ^ tq) << 5, vsw1 = ((2 + blk) ^ tq) << 5;
        const int dbase = q0 - 128 + 32 * qh + 4 * h - qp;
        f16x8 kf[4];
#define ATT_KREAD(j_) do { const int _ro = ((k0w + 32 * (j_)) & 511) << 7; _Pragma("unroll") for (int s = 0; s < 4; ++s) kf[s] = *(const LAS f16x8*)(kbase + _ro + (((2 * s + h) ^ ksw) << 4)); } while (0)
        f32x16 A;
#pragma unroll
        for (int i = 0; i < 16; ++i) A[i] = -m0;
        ATT_KREAD(0);
#pragma unroll
        for (int s = 0; s < 4; ++s) A = __builtin_amdgcn_mfma_f32_32x32x16_f16(kf[s], qf[s], A, 0, 0, 0);
        u32x4 gw[2][2];
        auto step = [&](const int j, auto mode_) __attribute__((always_inline)) {
            constexpr int MODE = decltype(mode_)::value;
            f32x16 S = A;
            if (MODE < 2) ATT_KREAD(j + 1);
            f16x8 vf[2][2];
#pragma unroll
            for (int sp = 0; sp < 2; ++sp) {
                LAS unsigned char* va = vbase + (((k0w + 32 * j) & 511) << 7) + 16 * sp * 128;
                vf[sp][0] = tr_pair(va + vsw0, va + 1024 + vsw0);
                vf[sp][1] = tr_pair(va + vsw1, va + 1024 + vsw1);
            }
            __builtin_amdgcn_sched_barrier(0);
            if (MODE < 2) {
#pragma unroll
                for (int i = 0; i < 16; ++i) A[i] = -m0;
#pragma unroll
                for (int s = 0; s < 4; ++s) A = __builtin_amdgcn_mfma_f32_32x32x16_f16(kf[s], qf[s], A, 0, 0, 0);
            }
            if (MODE == 1) { const int un = (unit + 1 < u_hi) ? unit + 1 : unit; ATT_QLOAD(un); }
            __builtin_amdgcn_sched_barrier(0);
            const int k0s = q0 - 128 + 32 * (qh + j);
            if (j == 0 || j == 8 || k0s < 0 || k0s + 32 > SEQ) {
                const int base = dbase + 32 * j;
#pragma unroll
                for (int i = 0; i < 16; ++i) { const int d0 = base + (i & 3) + 8 * (i >> 2); if (d0 < lo_d || d0 > hi_d) S[i] = -1e30f; }
            }

#pragma unroll
            for (int i = 0; i < 16; ++i) S[i] = __builtin_amdgcn_exp2f(S[i]);
            l += ((S[0] + S[1]) + (S[2] + S[3])) + ((S[4] + S[5]) + (S[6] + S[7])) + (((S[8] + S[9]) + (S[10] + S[11])) + ((S[12] + S[13]) + (S[14] + S[15])));
#pragma unroll
            for (int sp = 0; sp < 2; ++sp) {
                const f16x8 pf = pack_p(S, sp);
                O0 = __builtin_amdgcn_mfma_f32_32x32x16_f16(vf[sp][0], pf, O0, 0, 0, 0);
                O1 = __builtin_amdgcn_mfma_f32_32x32x16_f16(vf[sp][1], pf, O1, 0, 0, 0);
            }
        };
#pragma unroll 1
        for (int j = 0; j < FILL_STEP; ++j) step(j, std::integral_constant<int, 0>{});
        {
            const int c = tid & 7, rr = (q0 + 192 + (tid >> 3)) & 511;
            *(LAS u32x4*)(lds + rr * 128 + ((c ^ ((rr >> 1) & 7)) << 4)) = kn;
            *(LAS u32x4*)(lds + ATT_V + rr * 128 + (((c >> 1) ^ (rr & 3)) << 5) + ((c & 1) << 4)) = vn;
#pragma unroll
            for (int dt = 0; dt < 2; ++dt)
#pragma unroll
                for (int kk = 0; kk < 2; ++kk) gw[dt][kk] = *(const u32x4*)(GA + grow * 512 + head * 64 + 32 * dt + 8 * (2 * kk + h));
        }
#pragma unroll 1
        for (int j = FILL_STEP; j < 7; ++j) step(j, std::integral_constant<int, 0>{});
        step(7, std::integral_constant<int, 1>{});
        step(8, std::integral_constant<int, 2>{});
#undef ATT_KREAD
        const float inv = 1.0f / (l + __shfl_xor(l, 32));
#pragma unroll
        for (int dt = 0; dt < 2; ++dt)
#pragma unroll
            for (int kk = 0; kk < 2; ++kk) {
                u32x2 glo = {gw[dt][kk][0], gw[dt][kk][1]}, ghi = {gw[dt][kk][2], gw[dt][kk][3]};
#pragma unroll
                for (int w2 = 0; w2 < 2; ++w2) { const auto sw = __builtin_amdgcn_permlane32_swap(glo[w2], ghi[w2], false, false); glo[w2] = sw[0]; ghi[w2] = sw[1]; }
                const f16x4 g0 = __builtin_bit_cast(f16x4, glo), g1 = __builtin_bit_cast(f16x4, ghi);
                f16x4 o0, o1;
#pragma unroll
                for (int j = 0; j < 4; ++j) {
                    o0[j] = (f16)((dt ? O1[8 * kk + j] : O0[8 * kk + j]) * inv * (float)g0[j]);
                    o1[j] = (f16)((dt ? O1[8 * kk + 4 + j] : O0[8 * kk + 4 + j]) * inv * (float)g1[j]);
                }
                u32x2 a0 = __builtin_bit_cast(u32x2, o0), a1 = __builtin_bit_cast(u32x2, o1);
#pragma unroll
                for (int w2 = 0; w2 < 2; ++w2) { const auto sw = __builtin_amdgcn_permlane32_swap(a0[w2], a1[w2], false, false); a0[w2] = sw[0]; a1[w2] = sw[1]; }
                const u32x4 st = {a0[0], a0[1], a1[0], a1[1]};
                *(u32x4*)(MIX + grow * 1024 + head * 64 + 32 * dt + 8 * (2 * kk + h)) = st;
            }
    }
#undef ATT_LOAD
#undef ATT_QLOAD
}

__device__ void fft_tables(LAS unsigned char* lds) {
    LAS f16* CF = (LAS f16*)(lds + LDS_TAB); LAS f16* SF = CF + 4096; LAS f16* NSF = SF + 4096;
    for (int e = threadIdx.x; e < 4096; e += NTHREADS) {
        const int jj = e & 7, lane = (e >> 3) & 63, kt = (e >> 9) & 1, s = e >> 10, h = lane >> 5;
        const int n = 16 * s + 8 * (jj >> 2) + 4 * h + (jj & 3), k = 32 * kt + (lane & 31);
        float sn, cs; sincospif((float)((n * k) & 63) * (1.0f / 32.0f), &sn, &cs);
        CF[e] = (f16)(cs * 0.125f); SF[e] = (f16)(sn * 0.125f); NSF[e] = (f16)(-sn * 0.125f);
    }
}
__device__ void p0_twiddle(const Args& a) {
    f32x2* TW = (f32x2*)(a.ws + WS_TW);
    for (int idx = blockIdx.x * NTHREADS + threadIdx.x; idx < 4096; idx += gridDim.x * NTHREADS) {
        const int lane = idx & 63, reg = (idx >> 6) & 15, kt = (idx >> 10) & 1, mt = idx >> 11, h = lane >> 5;
        const int n2 = 32 * mt + (reg & 3) + 8 * (reg >> 2) + 4 * h, k1 = 32 * kt + (lane & 31);
        float sn, cs; sincospif((float)(n2 * k1) * (1.0f / 2048.0f), &sn, &cs);
        TW[((((mt * 2 + kt) * 8 + (reg >> 1)) * 64 + lane) << 1) + (reg & 1)] = (f32x2){cs, sn};
    }
}
__device__ void fft_phase(const Args& a, LAS unsigned char* lds) {
    int tid_ = threadIdx.x; asm volatile("" : "+v"(tid_)); const int tid = tid_;
    const int lane = tid & 63, wid = __builtin_amdgcn_readfirstlane(tid >> 6), r = lane & 31, h = lane >> 5;
    const f16* Z = (const f16*)(a.ws + WS_Z); const f16* GF = (const f16*)(a.ws + WS_GF);
    const f32x2* TW = (const f32x2*)(a.ws + WS_TW);
    f16* FOUR = (f16*)(a.ws + WS_FOUR);
    const int G = gridDim.x;
    int unit = blockIdx.x;
    if (unit >= 768) return;
    f16x8 pin[4][4];
#define FFT_LOAD(un) do { const size_t _b0 = (size_t)(((un) >> 6) * 4 + (((un) >> 4) & 3)) * 16 + ((un) & 15); \
        int _tl = tid; asm volatile("" : "+v"(_tl)); \
        _Pragma("unroll") for (int it = 0; it < 4; ++it) { const f16* zp = Z + (_b0 * 4096 + 2 * (_tl + NTHREADS * it)) * 16; \
            _Pragma("unroll") for (int q = 0; q < 4; ++q) pin[it][q] = *(const f16x8*)(zp + 8 * q); } } while (0)
    FFT_LOAD(unit);
#pragma unroll 1
    for (; unit < 768; unit += G) {
    const int cg8 = unit & 15, g = (unit >> 4) & 3, b = unit >> 6;
    const size_t blk0 = (size_t)((b * 4 + g) * 16 + cg8) * 4096;
    __syncthreads();
#pragma unroll
    for (int it = 0; it < 4; ++it) {
        const int token = 2 * (tid + NTHREADS * it);
        const int n1 = token >> 6, n2 = token & 63;
        const int off = n1 * 128 + (((n2 >> 4) ^ (n1 & 3)) << 5) + (n2 & 15) * 2;
#pragma unroll
        for (int ch = 0; ch < 8; ++ch) {
            *(LAS f16x2*)(lds + ch * 16384 + off) = (f16x2){pin[it][0][ch], pin[it][2][ch]};
            *(LAS f16x2*)(lds + ch * 16384 + 8192 + off) = (f16x2){pin[it][1][ch], pin[it][3][ch]};
        }
    }
    __syncthreads();
    LAS unsigned char* img = lds + wid * 16384;
    const LAS f16x8* CF = (const LAS f16x8*)(lds + LDS_TAB) + lane; const LAS f16x8* SF = CF + 512; const LAS f16x8* NSF = SF + 512;
    const int blk = (lane >> 4) & 1, tq = (lane & 15) >> 2, tp = lane & 3;
    f32x16 X[2][2];
#pragma unroll
    for (int i = 0; i < 2; ++i)
#pragma unroll
        for (int j = 0; j < 2; ++j)
#pragma unroll
            for (int e = 0; e < 16; ++e) X[i][j][e] = 0.f;
#pragma unroll
    for (int mt = 0; mt < 2; ++mt) {
        f32x16 Yr[2], Yi[2];
#pragma unroll
        for (int j = 0; j < 2; ++j)
#pragma unroll
            for (int e = 0; e < 16; ++e) { Yr[j][e] = 0.f; Yi[j][e] = 0.f; }
#pragma unroll
        for (int which = 0; which < 2; ++which)
#pragma unroll
            for (int s = 0; s < 4; ++s) {
                LAS unsigned char* pa = img + which * 8192 + (16 * s + 4 * h + tq) * 128 + (((2 * mt + blk) ^ tq) << 5) + tp * 8;
                const f16x8 af = tr_pair(pa, pa + 8 * 128);
#pragma unroll
                for (int kt = 0; kt < 2; ++kt) {
                    const f16x8 cf = CF[(s * 2 + kt) * 64], sf = which ? NSF[(s * 2 + kt) * 64] : SF[(s * 2 + kt) * 64];
                    if (which == 0) { Yr[kt] = __builtin_amdgcn_mfma_f32_32x32x16_f16(af, cf, Yr[kt], 0, 0, 0); Yi[kt] = __builtin_amdgcn_mfma_f32_32x32x16_f16(af, sf, Yi[kt], 0, 0, 0); }
                    else { Yr[kt] = __builtin_amdgcn_mfma_f32_32x32x16_f16(af, sf, Yr[kt], 0, 0, 0); Yi[kt] = __builtin_amdgcn_mfma_f32_32x32x16_f16(af, cf, Yi[kt], 0, 0, 0); }
                }
            }
        f16x8 trf[2][2], tif[2][2];
#pragma unroll
        for (int kt = 0; kt < 2; ++kt) {
            int lane_l = lane; asm volatile("" : "+v"(lane_l));
            const f32x4* tw = (const f32x4*)TW + ((mt * 2 + kt) * 8) * 64 + lane_l;
            f32x16 tr, ti;
#pragma unroll
            for (int p = 0; p < 8; ++p) { const f32x4 cs = tw[p * 64];
                tr[2 * p] = Yr[kt][2 * p] * cs[0] - Yi[kt][2 * p] * cs[1]; ti[2 * p] = Yr[kt][2 * p] * cs[1] + Yi[kt][2 * p] * cs[0];
                tr[2 * p + 1] = Yr[kt][2 * p + 1] * cs[2] - Yi[kt][2 * p + 1] * cs[3]; ti[2 * p + 1] = Yr[kt][2 * p + 1] * cs[3] + Yi[kt][2 * p + 1] * cs[2]; }
#pragma unroll
            for (int sp = 0; sp < 2; ++sp) { trf[kt][sp] = pack_p(tr, sp); tif[kt][sp] = pack_p(ti, sp); }
        }
#pragma unroll
        for (int sp = 0; sp < 2; ++sp)
#pragma unroll
            for (int mt2 = 0; mt2 < 2; ++mt2) {
                const f16x8 cf = CF[((2 * mt + sp) * 2 + mt2) * 64], nsf = NSF[((2 * mt + sp) * 2 + mt2) * 64];
#pragma unroll
                for (int kt = 0; kt < 2; ++kt) {
                    X[mt2][kt] = __builtin_amdgcn_mfma_f32_32x32x16_f16(cf, trf[kt][sp], X[mt2][kt], 0, 0, 0);
                    X[mt2][kt] = __builtin_amdgcn_mfma_f32_32x32x16_f16(nsf, tif[kt][sp], X[mt2][kt], 0, 0, 0);
                }
            }
    }
#pragma unroll
    for (int mt2 = 0; mt2 < 2; ++mt2)
#pragma unroll
        for (int kt = 0; kt < 2; ++kt)
#pragma unroll
            for (int e = 0; e < 16; ++e) {
                const int token = 32 * kt + r + 64 * (32 * mt2 + (e & 3) + 8 * (e >> 2) + 4 * h);
                *(LAS f16*)(img + token * 2) = (f16)X[mt2][kt][e];
            }
    f16x8 gt[4][2];
    int tl = tid; asm volatile("" : "+v"(tl));
#pragma unroll
    for (int it = 0; it < 4; ++it) { const f16* gp = GF + (blk0 + 2 * (tl + NTHREADS * it)) * 8; gt[it][0] = *(const f16x8*)gp; gt[it][1] = *(const f16x8*)(gp + 8); }
    { const int un = (unit + G < 768) ? unit + G : unit; FFT_LOAD(un); }
    __syncthreads();
#pragma unroll
    for (int it = 0; it < 4; ++it) {
        const int token = 2 * (tl + NTHREADS * it);
        f16x8 o0, o1;
#pragma unroll
        for (int ch = 0; ch < 8; ++ch) {
            const f16x2 v = *(const LAS f16x2*)(lds + ch * 16384 + token * 2);
            o0[ch] = (f16)((float)v[0] * (float)gt[it][0][ch]); o1[ch] = (f16)((float)v[1] * (float)gt[it][1][ch]);
        }
        *(f16x8*)(FOUR + (blk0 + token) * 8) = o0; *(f16x8*)(FOUR + (blk0 + token) * 8 + 8) = o1;
    }
    }
#undef FFT_LOAD
}

#define XB_TMO      128
#define XB_XCNT(j)  (256  + 64 * (j))
#define XB_XSUB(j)  (1280 + 64 * (j))
#define XB_XGEN(j)  (2304 + 64 * (j))
#define XB_TOP      3328
#define XB_TOPGEN   3392
#define XCD_BAR_WORDS 3456
#define XB_SPIN_CAP (1u << 18)
__device__ __forceinline__ unsigned xb_ld(unsigned* p)              { return __hip_atomic_load(p, __ATOMIC_RELAXED, __HIP_MEMORY_SCOPE_AGENT); }
__device__ __forceinline__ unsigned xb_add(unsigned* p, unsigned v) { return __hip_atomic_fetch_add(p, v, __ATOMIC_RELAXED, __HIP_MEMORY_SCOPE_AGENT); }
__device__ __forceinline__ unsigned xb_xcc_id() { return (unsigned)__builtin_amdgcn_s_getreg((3 << 11) | 20) & 0xFu; }
#define XB_SPIN(cond, bar) do { unsigned _sp = 0; while (cond) { __builtin_amdgcn_s_sleep(1); \
    if ((++_sp & 255u) == 0u) { if (xb_ld(&(bar)[XB_TMO])) break; if (_sp > XB_SPIN_CAP) { atomicAdd(&(bar)[XB_TMO], 1u); break; } } } } while (0)
struct XcdBarrier { unsigned* bar; unsigned x; volatile LAS unsigned* st; };
__device__ __forceinline__ XcdBarrier xcd_barrier_post(unsigned* bar, volatile LAS unsigned* st) {
    XcdBarrier b; b.bar = bar; b.x = xb_xcc_id(); b.st = st;
    if (threadIdx.x == 0) (void)xb_add(&bar[XB_XCNT(b.x)], 1u);
    return b;
}
__device__ __forceinline__ void xcd_barrier_complete(unsigned* bar, unsigned x, unsigned& nloc, unsigned& nx) {
    const unsigned G = gridDim.x * gridDim.y * gridDim.z;
    unsigned sum, cnt, mine, sp = 0u;
    for (;;) {
        sum = 0u; cnt = 0u; mine = 0u;
#pragma unroll 1
        for (unsigned j = 0; j < 16; ++j) { const unsigned c = xb_ld(&bar[XB_XCNT(j)]); sum += c; cnt += (c > 0u) ? 1u : 0u; mine = (j == x) ? c : mine; }
        if (sum == G) break;
        __builtin_amdgcn_s_sleep(1);
        if ((++sp & 255u) == 0u) { if (xb_ld(&bar[XB_TMO])) break; if (sp > XB_SPIN_CAP) { atomicAdd(&bar[XB_TMO], 1u); break; } }
    }
    nloc = mine > 0u ? mine : 1u; nx = cnt > 0u ? cnt : 1u;
}
__device__ __forceinline__ void xcd_barrier(const XcdBarrier& b) {
    asm volatile("s_waitcnt vmcnt(0)" ::: "memory");
    __syncthreads();
    if (threadIdx.x == 0) {
        unsigned* bar = b.bar; asm volatile("" : "+s"(bar));
        __builtin_amdgcn_s_waitcnt(0);
        unsigned nloc = b.st[0], nx = b.st[1];
        if (nloc == 0u) { xcd_barrier_complete(bar, b.x, nloc, nx); b.st[0] = nloc; b.st[1] = nx; }
        const unsigned old = xb_add(&bar[XB_XSUB(b.x)], 1u);
        const unsigned gen = old / nloc;
        if (old + 1u == (gen + 1u) * nloc) {
            __builtin_amdgcn_fence(__ATOMIC_RELEASE, "agent");
            asm volatile("s_waitcnt vmcnt(0)" ::: "memory");
            const unsigned og = xb_add(&bar[XB_TOP], 1u);
            const unsigned tg = og / nx;
            if (og + 1u == (tg + 1u) * nx) xb_add(&bar[XB_TOPGEN], 1u);
            else XB_SPIN(xb_ld(&bar[XB_TOPGEN]) == tg, bar);
            __builtin_amdgcn_fence(__ATOMIC_ACQUIRE, "agent");
            xb_add(&bar[XB_XGEN(b.x)], 1u);
            asm volatile("s_waitcnt vmcnt(0)" ::: "memory");
        } else {
            XB_SPIN(xb_ld(&bar[XB_XGEN(b.x)]) == gen, bar);
            __builtin_amdgcn_fence(__ATOMIC_ACQUIRE, "agent");
            asm volatile("s_waitcnt vmcnt(0)" ::: "memory");
        }
    }
    __syncthreads();
}

__global__ void __launch_bounds__(NTHREADS, 2) hymba_fwd(Args a) {
    extern __shared__ __attribute__((aligned(16))) unsigned char lds_raw[];
    LAS unsigned char* lds = (LAS unsigned char*)lds_raw;
    if (threadIdx.x < 2) ((volatile LAS unsigned*)(lds + LDS_MISC))[threadIdx.x] = 0u;
    __syncthreads();
    const XcdBarrier bar = xcd_barrier_post((unsigned*)(a.ws + WS_BAR), (volatile LAS unsigned*)(lds + LDS_MISC));
    const int lo = a.ph_lo, hi = a.ph_hi;
#define IN(k) (lo <= (k) && (k) < hi)
#define SEAM(k) do { if (IN(k) && IN((k) + 1)) xcd_barrier(bar); } while (0)
    if (IN(0)) { p0_mmat(a, lds); p0_rope(a); p0_twiddle(a); p_weights_plain(a); }
    SEAM(0);
    if (IN(1)) { p_weights_prod(a, lds); p0_xconv(a); }
    fft_tables(lds);
    SEAM(1);
#pragma unroll 1
    for (int layer = 0; layer < 2; ++layer) {
        const int pb = 2 + 3 * layer;
        if (IN(pb)) {
            pg8::Gemm g{(const f16*)(a.ws + WS_XH), (const f16*)(a.ws + WS_W1T) + (size_t)layer * N1 * 1024, MROWS, N1, 1024, nullptr};
            pg8::StaticOrder S; S.init(MROWS, N1, gridDim.x, blockIdx.x);
            const bool split = (gridDim.x == 256);
            if (split) S.hi = 2048;
            Epi1 E{a.ws, a.qgain + layer * 64, a.kgain + layer * 64};
            pg8::gemm_phase<Epi1, false>(lds, g, S, E);
            if (split) {
                unsigned* tailq = (unsigned*)(a.ws + WS_BAR) + 3584 + 64 * layer;
                volatile LAS unsigned* qslot = (volatile LAS unsigned*)(lds + LDS_MISC) + 8;
                for (;;) {
                    if (threadIdx.x == 0) *qslot = __hip_atomic_fetch_add(tailq, 1u, __ATOMIC_RELAXED, __HIP_MEMORY_SCOPE_AGENT);
                    __syncthreads();
                    const unsigned q = *qslot;
                    __syncthreads();
                    if (q >= 256u) break;
                    pg8::Unit tu; S.unit_of(2048 + (int)(q >> 2), tu);
                    gemm1_tail_quadrant(lds, g.A, g.Bt, a.ws, tu.pm, tu.pn, (int)((q >> 1) & 1u), (int)(q & 1u));
                }
            }
        }
        SEAM(pb);
        if (IN(pb + 1)) {
#pragma unroll 1
            for (int part = 0; part < 2; ++part) {
                if ((part ^ (int)((blockIdx.x >> 3) & 1)) == 0) attn_phase(a, lds, layer);
                else fft_phase(a, lds);
            }
        }
        SEAM(pb + 1);
        if (IN(pb + 2)) {
            pg8::Gemm g{(const f16*)(a.ws + WS_MIX), (const f16*)(a.ws + WS_W2T) + (size_t)layer * 1024 * 1024, MROWS, 1024, 1024, (const f16*)(a.ws + WS_FOUR)};
            pg8::StaticOrder S; S.init(MROWS, 1024, gridDim.x, blockIdx.x);
            Epi2 E{a.x_prompt, a.x_sample, a.out, (f16*)(a.ws + WS_XH), (float*)(a.ws + WS_SS), layer};
            pg8::gemm_phase<Epi2, true>(lds, g, S, E);
        }
        if (layer == 0) SEAM(pb + 2);
    }
#undef IN
#undef SEAM
}

extern "C" void kernel_launch(void* const* d_in, const int* in_sizes, int n_in, void* d_out, int out_size, void* d_ws, size_t ws_size, hipStream_t stream) {
    static int grid = 0;
    if (grid == 0) {
        int dev = 0, cus = 0, per_cu = 0;
        hipGetDevice(&dev);
        hipDeviceGetAttribute(&cus, hipDeviceAttributeMultiprocessorCount, dev);
        hipFuncSetAttribute((const void*)hymba_fwd, hipFuncAttributeMaxDynamicSharedMemorySize, LDS_BYTES);
        hipOccupancyMaxActiveBlocksPerMultiprocessor(&per_cu, (const void*)hymba_fwd, NTHREADS, LDS_BYTES);
        if (per_cu < 1) { fprintf(stderr, "kernel_launch: occupancy query says %d blocks/CU\n", per_cu); per_cu = 1; }
        if (per_cu > 1) per_cu = 1;
        grid = cus * per_cu;
        if (ws_size < WS_END) { fprintf(stderr, "kernel_launch: workspace too small (%zu < %zu)\n", ws_size, (size_t)WS_END); grid = -1; }
    }
    if (grid < 0) return;
    hipMemsetAsync((char*)d_ws + WS_BAR, 0, 16384, stream);
    Args a{};
    a.x_prompt = (const float*)d_in[0]; a.x_sample = (const float*)d_in[1]; a.norm_gain = (const float*)d_in[2]; a.w_in = (const float*)d_in[3];
    a.qgain = (const float*)d_in[4]; a.kgain = (const float*)d_in[5]; a.sink = (const float*)d_in[6]; a.w_four = (const float*)d_in[7]; a.w_out = (const float*)d_in[8];
    a.out = (float*)d_out; a.ws = (unsigned char*)d_ws; a.ph_lo = 0; a.ph_hi = 8;
    void* args[] = {&a};
    hipError_t e = hipLaunchCooperativeKernel((const void*)hymba_fwd, dim3(grid), dim3(NTHREADS), args, LDS_BYTES, stream);
    if (e != hipSuccess) fprintf(stderr, "kernel_launch: cooperative launch failed: %s (grid %d)\n", hipGetErrorString(e), grid);
}
```
